# Optimizing an MI355X kernel written in HIP

```python
import math
import jax, jax.numpy as jnp
from jax import lax
import numpy as np

D_MODEL = 1024
BATCH = 16
SEQ = 2048
DEPTH = 4

CHUNK = 64
N_META = 16
CONV_W = 3
N_HEADS = 8
HEAD_DIM = D_MODEL // N_HEADS // 2
V_DIM = 2 * HEAD_DIM
Q_BLOCK = 128
N_A = max(1, DEPTH // 2)
N_B = DEPTH - N_A
EPS = 1e-6

kernel_name = "yoco_shortconv_diffattn_meta"


def rmsnorm(x, g):
    xf = x.astype(jnp.float32)
    y = xf * lax.rsqrt(jnp.mean(xf * xf, axis=-1, keepdims=True) + EPS)
    return (y * g.astype(jnp.float32)).astype(x.dtype)


def chunk_ids(n):
    p = jnp.arange(n)
    return jnp.where(p < N_META, 0, 1 + (p - N_META) // CHUNK)


def lambda_init_fn(depth):
    return 0.8 - 0.6 * math.exp(-0.3 * depth)


def short_conv_mixer(h, g, w_in, conv_w, conv_b, w_out):
    L = h.shape[1]
    u = rmsnorm(h, g) @ w_in
    b_gate, c_gate, h_in, z = jnp.split(u, 4, axis=-1)
    v = c_gate * h_in
    vp = jnp.pad(v, ((0, 0), (CONV_W - 1, 0), (0, 0)))
    conv = conv_w[0] * vp[:, 0:L]
    for j in range(1, CONV_W):
        conv = conv + conv_w[j] * vp[:, j:j + L]
    conv = conv + conv_b
    y = b_gate * conv * jax.nn.silu(z)
    return y @ w_out


def diff_attention_core(q, k, v, lam):
    bsz, L = q.shape[0], q.shape[1]
    n_blocks = -(-L // Q_BLOCK)
    Lp = n_blocks * Q_BLOCK
    qp = jnp.pad(q, ((0, 0), (0, Lp - L), (0, 0), (0, 0), (0, 0)))
    qb = qp.reshape(bsz, n_blocks, Q_BLOCK, N_HEADS, 2, HEAD_DIM).transpose(1, 0, 2, 3, 4, 5)
    qcid = chunk_ids(Lp).reshape(n_blocks, Q_BLOCK)
    kcid = chunk_ids(L)
    kf = k.astype(jnp.float32)
    vf = v.astype(jnp.float32)
    scale = HEAD_DIM ** -0.5

    def block(args):
        qi, ci = args
        s = jnp.einsum('bqhcd,bkhcd->bhcqk', qi.astype(jnp.float32), kf) * scale
        mask = ci[:, None] >= kcid[None, :]
        s = jnp.where(mask[None, None, None], s, -jnp.inf)
        p = jax.nn.softmax(s, axis=-1)
        attn = p[:, :, 0] - lam * p[:, :, 1]
        return jnp.einsum('bhqk,bkhe->bqhe', attn, vf)

    o = lax.map(block, (qb, qcid))
    o = o.transpose(1, 0, 2, 3, 4).reshape(bsz, Lp, N_HEADS, V_DIM)
    return o[:, :L]


def diff_attn_mixer(h, g, w_in, lq1, lk1, lq2, lk2, subln_g, w_out, k, v, lambda_init):
    bsz, L, _ = h.shape
    u = rmsnorm(h, g) @ w_in
    q, z = jnp.split(u, 2, axis=-1)
    q = q.reshape(bsz, L, N_HEADS, 2, HEAD_DIM)
    lam = (jnp.exp(jnp.sum(lq1.astype(jnp.float32) * lk1.astype(jnp.float32)))
           - jnp.exp(jnp.sum(lq2.astype(jnp.float32) * lk2.astype(jnp.float32)))
           + lambda_init)
    o = diff_attention_core(q, k, v, lam)
    o = rmsnorm(o, subln_g) * (1.0 - lambda_init)
    o = o.reshape(bsz, L, N_HEADS * V_DIM).astype(h.dtype) * jax.nn.silu(z)
    return o @ w_out


def setup_inputs(seed: int = 0) -> dict:
    key = jax.random.key(seed)
    ks = jax.random.split(key, 20)
    D = D_MODEL
    s = D ** -0.5
    nrm = lambda k, shp, sc: jax.random.normal(k, shp, jnp.float32) * sc
    return {
        "x": nrm(ks[0], (BATCH, SEQ, D), 1.0),
        "meta_tokens": nrm(ks[1], (N_META, D), 1.0),
        "a_norm_g": 1.0 + nrm(ks[2], (N_A, D), 0.02),
        "a_w_in": nrm(ks[3], (N_A, D, 4 * D), s),
        "a_conv_w": nrm(ks[4], (N_A, CONV_W, D), CONV_W ** -0.5),
        "a_conv_b": nrm(ks[5], (N_A, D), 0.02),
        "a_w_out": nrm(ks[6], (N_A, D, D), s),
        "kv_norm_g": 1.0 + nrm(ks[7], (D,), 0.02),
        "w_kv": nrm(ks[8], (D, 2 * D), s),
        "b_norm_g": 1.0 + nrm(ks[9], (N_B, D), 0.02),
        "b_w_in": nrm(ks[10], (N_B, D, 2 * D), s),
        "b_lambda_q1": nrm(ks[11], (N_B, HEAD_DIM), 0.1),
        "b_lambda_k1": nrm(ks[12], (N_B, HEAD_DIM), 0.1),
        "b_lambda_q2": nrm(ks[13], (N_B, HEAD_DIM), 0.1),
        "b_lambda_k2": nrm(ks[14], (N_B, HEAD_DIM), 0.1),
        "b_subln_g": 1.0 + nrm(ks[15], (N_B, V_DIM), 0.02),
        "b_w_out": nrm(ks[16], (N_B, D, D), s),
        "final_norm_g": 1.0 + nrm(ks[17], (D,), 0.02),
    }


def reference(x, meta_tokens, a_norm_g, a_w_in, a_conv_w, a_conv_b, a_w_out,
              kv_norm_g, w_kv, b_norm_g, b_w_in, b_lambda_q1, b_lambda_k1,
              b_lambda_q2, b_lambda_k2, b_subln_g, b_w_out, final_norm_g):
    bsz = x.shape[0]
    meta = jnp.broadcast_to(meta_tokens[None].astype(x.dtype), (bsz, N_META, D_MODEL))
    h = jnp.concatenate([meta, x], axis=1)
    L = h.shape[1]
    k_sh = None
    v_sh = None
    for i in range(DEPTH):
        if i < N_A:
            h = h + short_conv_mixer(h, a_norm_g[i], a_w_in[i], a_conv_w[i],
                                     a_conv_b[i], a_w_out[i])
            if i == N_A - 1:
                kv = rmsnorm(h, kv_norm_g) @ w_kv
                k_sh = kv[..., :D_MODEL].reshape(bsz, L, N_HEADS, 2, HEAD_DIM)
                v_sh = kv[..., D_MODEL:].reshape(bsz, L, N_HEADS, V_DIM)
        else:
            j = i - N_A
            h = h + diff_attn_mixer(h, b_norm_g[j], b_w_in[j], b_lambda_q1[j],
                                    b_lambda_k1[j], b_lambda_q2[j], b_lambda_k2[j],
                                    b_subln_g[j], b_w_out[j], k_sh, v_sh,
                                    lambda_init_fn(i))
    h = rmsnorm(h, final_norm_g)
    return h[:, N_META:]
```

```cpp
#include <hip/hip_runtime.h>
#include <hip/hip_cooperative_groups.h>
#include <cstdio>
#include <cstdint>
namespace cg = cooperative_groups;
#define ATT_VCU vcu
namespace pg8 {
#define PG8_LAS __attribute__((address_space(3)))
typedef unsigned short bf16_t;
typedef short bf16x8 __attribute__((ext_vector_type(8)));
typedef float f32x4 __attribute__((ext_vector_type(4)));
typedef unsigned u32x4 __attribute__((ext_vector_type(4)));
constexpr int BM = 256, BK = 64, HALF = 128, HTB = HALF * BK * 2  , STAGE_BYTES = 8 * HTB, NXCD = 8, WGM = 4;

__host__ __device__ __forceinline__ int lds_byte(int r, int c) { const int st = (r >> 4) * 2 + (c >> 5), rr = r & 15, cc = c & 31, ob = rr * 64 + cc * 2; return st * 1024 + (ob ^ (((ob >> 9) & 1) << 5)); }
__host__ __device__ __forceinline__ void stage_rc(int b, int& R, int& C) { const int st = b / 1024, sb = b % 1024, swz = sb ^ (((sb >> 9) & 1) << 5); R = (st >> 1) * 16 + swz / 64; C = (st & 1) * 32 + (swz % 64) / 2; }
__host__ __device__ __forceinline__ int perm32(int rho) { const int n = rho >> 4, i = rho & 15; return 8 * (i >> 2) + 4 * n + (i & 3); }

struct Unit { int pm, pn; };
struct Gemm { const bf16_t* A; const bf16_t* Bt; int M, N, K; };

struct StaticOrder {
    int nM, nN, nwg, G, c;
    __host__ __device__ void init(int M, int N, int G_, int c_) { nM = M / BM; nN = N / BM; nwg = nM * nN; G = G_; c = c_; }
    __host__ __device__ bool next(int i, Unit& u) const {
        const long L = (long)i * G + c; if (L >= nwg) return false;
        int wgid = (int)L; { const int q = nwg / NXCD, r = nwg % NXCD, xcd = wgid % NXCD, off = wgid / NXCD; wgid = (xcd < r ? xcd * (q + 1) : r * (q + 1) + (xcd - r) * q) + off; }
        const int nig = WGM * nN, gid = wgid / nig, fm = gid * WGM, gsz = (nM - fm) < WGM ? (nM - fm) : WGM;
        u.pm = fm + ((wgid % nig) % gsz); u.pn = (wgid % nig) / gsz; return true;
    }
    __device__ __forceinline__ void a_ready(const Unit&) const {}
    __device__ __forceinline__ void done(const Unit&) const {}
};

__device__ __forceinline__ unsigned cvt_pk_bf16(float lo, float hi) { unsigned r; asm volatile("v_cvt_pk_bf16_f32 %0, %1, %2" : "=v"(r) : "v"(lo), "v"(hi)); return r; }
typedef float f32x2 __attribute__((ext_vector_type(2)));
template <class Epi, class Sched, bool ALIGN_EPI = false, bool SP2 = false>
__device__ __forceinline__ void gemm_phase(PG8_LAS unsigned char* lds, const Gemm g, const Sched& S, const Epi& E) {
    int tid = threadIdx.x; asm volatile("" : "+v"(tid)); const int wid = __builtin_amdgcn_readfirstlane(tid >> 6), lane = tid & 63, wr = wid >> 2, wc = wid & 3, fr = lane & 15, fq = lane >> 4;
    const int K = g.K, nt = K / BK;
    unsigned voffA[2], voffB[2];
#pragma unroll
    for (int i = 0; i < 2; ++i) { int R, C; stage_rc(tid * 16 + i * 8192, R, C); const int Rb = Epi::PERM ? ((R & ~31) + perm32(R & 31)) : R;
        voffA[i] = (unsigned)(R * K + C) * 2u; voffB[i] = (unsigned)(Rb * K + C) * 2u; }
    const size_t kstep = (size_t)(BK * 2);
    const size_t hstep = (size_t)HALF * K * 2;
    const size_t tstep = 2 * hstep;
    const unsigned ldsw = (unsigned)wid * 1024u;
    const int aoff = lds_byte(wr * 64 + fr, fq * 8), boff = lds_byte(wc * 32 + fr, fq * 8);
#define PG8_SA(b, h) (((b) * 2 + (h)) * HTB)
#define PG8_SB(b, h) ((4 + (b) * 2 + (h)) * HTB)
#define PG8_STAGE(bufoff, gbase, voff) do { _Pragma("unroll") for (int _i = 0; _i < 2; ++_i) \
        __builtin_amdgcn_global_load_lds((const unsigned*)((const char*)(gbase) + (voff)[_i]), (PG8_LAS unsigned*)(lds + (bufoff) + ldsw + _i * 8192), 16, 0, 0); } while (0)
#define PG8_LDA(dst, b, h) do { _Pragma("unroll") for (int m = 0; m < 4; ++m) _Pragma("unroll") for (int k = 0; k < 2; ++k) dst[m][k] = *(const PG8_LAS bf16x8*)(lds + PG8_SA(b, h) + aoff + m * 2048 + k * 1024); } while (0)
#define PG8_LDB(dst, b, h) do { _Pragma("unroll") for (int n = 0; n < 2; ++n) _Pragma("unroll") for (int k = 0; k < 2; ++k) dst[n][k] = *(const PG8_LAS bf16x8*)(lds + PG8_SB(b, h) + boff + n * 2048 + k * 1024); } while (0)
#define PG8_MMA(ai, bj, At, Bt) do { __builtin_amdgcn_s_setprio(1); _Pragma("unroll") for (int m = 0; m < 4; ++m) _Pragma("unroll") for (int n = 0; n < 2; ++n) _Pragma("unroll") for (int k = 0; k < 2; ++k) \
        acc[ai][bj][m][n] = __builtin_amdgcn_mfma_f32_16x16x32_bf16(Bt[n][k], At[m][k], acc[ai][bj][m][n], 0, 0, 0); __builtin_amdgcn_s_setprio(0); } while (0)
#define PG8_WAIT_V(n) asm volatile("s_waitcnt vmcnt(" #n ")" ::: "memory")
#define PG8_WAIT_L(n) asm volatile("s_waitcnt lgkmcnt(" #n ")" ::: "memory")
#define PG8_BAR __builtin_amdgcn_s_barrier()
#define PG8_SCHED __builtin_amdgcn_sched_barrier(0)
    Unit cur, nxt; int ui = 0;
    if (!S.next(0, cur)) return;
    f32x4 acc[2][2][4][2];
#pragma unroll
    for (int a = 0; a < 2; ++a)
#pragma unroll
        for (int b = 0; b < 2; ++b)
#pragma unroll
            for (int m = 0; m < 4; ++m)
#pragma unroll
                for (int n = 0; n < 2; ++n) acc[a][b][m][n] = (f32x4){0.f, 0.f, 0.f, 0.f};
    bf16x8 At[4][2], B0[2][2], B1[2][2];
    const char* cA = (const char*)g.A + (size_t)cur.pm * tstep; const char* cB = (const char*)g.Bt + (size_t)cur.pn * tstep;
    S.a_ready(cur);
    if constexpr (SP2) {
        PG8_STAGE(PG8_SB(0, 0), cB, voffB); PG8_STAGE(PG8_SB(0, 1), cB + hstep, voffB); PG8_STAGE(PG8_SA(0, 0), cA, voffA); PG8_STAGE(PG8_SA(0, 1), cA + hstep, voffA);
        if (wr == 1) PG8_BAR;
        PG8_WAIT_V(2); PG8_BAR;
        PG8_STAGE(PG8_SB(1, 0), cB + kstep, voffB); PG8_STAGE(PG8_SA(1, 0), cA + kstep, voffA); PG8_STAGE(PG8_SB(1, 1), cB + hstep + kstep, voffB);
        PG8_WAIT_V(6); PG8_BAR;
    } else {
        PG8_STAGE(PG8_SB(0, 0), cB, voffB); PG8_STAGE(PG8_SA(0, 0), cA, voffA); PG8_STAGE(PG8_SB(0, 1), cB + hstep, voffB); PG8_STAGE(PG8_SA(0, 1), cA + hstep, voffA);
        if (wr == 1) PG8_BAR;
        PG8_WAIT_V(4); PG8_BAR;
        PG8_STAGE(PG8_SB(1, 0), cB + kstep, voffB); PG8_STAGE(PG8_SA(1, 0), cA + kstep, voffA); PG8_STAGE(PG8_SB(1, 1), cB + hstep + kstep, voffB);
        PG8_WAIT_V(6); PG8_BAR;
    }
    for (;;) {
        const bool has_next = S.next(ui + 1, nxt);
        const char* nA = has_next ? (const char*)g.A + (size_t)nxt.pm * tstep : cA; const char* nB = has_next ? (const char*)g.Bt + (size_t)nxt.pn * tstep : cB;
        for (int t = 0; t < nt; t += 2) {
            const bool last = (t == nt - 2);
            const char* a1 = cA + (size_t)(t + 1) * kstep;
            const char* a2 = last ? nA : cA + (size_t)(t + 2) * kstep; const char* b2 = last ? nB : cB + (size_t)(t + 2) * kstep;
            const char* a3 = a2 + kstep; const char* b3 = b2 + kstep;
            if (last && has_next) S.a_ready(nxt);
            if constexpr (SP2) {
            PG8_LDB(B0, 0, 0); PG8_LDB(B1, 0, 1); PG8_SCHED; PG8_LDA(At, 0, 0); PG8_STAGE(PG8_SA(1, 1), a1 + hstep, voffA);
            PG8_WAIT_V(8); PG8_WAIT_L(0); PG8_BAR; PG8_MMA(0, 0, At, B0); PG8_MMA(0, 1, At, B1); PG8_BAR; PG8_SCHED;
            PG8_LDA(At, 0, 1); PG8_STAGE(PG8_SB(0, 0), b2, voffB); PG8_STAGE(PG8_SB(0, 1), b2 + hstep, voffB); PG8_STAGE(PG8_SA(0, 0), a2, voffA);
            PG8_WAIT_V(8); PG8_WAIT_L(0); PG8_BAR; PG8_MMA(1, 0, At, B0); PG8_MMA(1, 1, At, B1); PG8_BAR; PG8_SCHED;
            PG8_LDB(B0, 1, 0); PG8_LDB(B1, 1, 1); PG8_SCHED; PG8_LDA(At, 1, 0); PG8_STAGE(PG8_SA(0, 1), a2 + hstep, voffA);
            PG8_WAIT_V(8); PG8_WAIT_L(0); PG8_BAR; PG8_MMA(0, 0, At, B0); PG8_MMA(0, 1, At, B1); PG8_BAR; PG8_SCHED;
            PG8_LDA(At, 1, 1); PG8_STAGE(PG8_SB(1, 0), b3, voffB); PG8_STAGE(PG8_SB(1, 1), b3 + hstep, voffB); PG8_STAGE(PG8_SA(1, 0), a3, voffA);
            PG8_WAIT_V(8); PG8_WAIT_L(0); PG8_BAR; PG8_MMA(1, 0, At, B0); PG8_MMA(1, 1, At, B1); PG8_BAR; PG8_SCHED;
            } else {
            PG8_LDB(B0, 0, 0); PG8_SCHED; PG8_LDA(At, 0, 0); PG8_STAGE(PG8_SA(1, 1), a1 + hstep, voffA);
            PG8_WAIT_L(8); PG8_BAR; PG8_WAIT_L(0); PG8_MMA(0, 0, At, B0); PG8_BAR; PG8_SCHED;
            PG8_LDB(B1, 0, 1); PG8_STAGE(PG8_SB(0, 0), b2, voffB);
            PG8_BAR; PG8_WAIT_L(0); PG8_MMA(0, 1, At, B1); PG8_BAR;
            PG8_LDA(At, 0, 1); PG8_STAGE(PG8_SA(0, 0), a2, voffA);
            PG8_BAR; PG8_WAIT_L(0); PG8_MMA(1, 0, At, B0); PG8_BAR; PG8_SCHED;
            PG8_STAGE(PG8_SB(0, 1), b2 + hstep, voffB);
            PG8_WAIT_V(6); PG8_BAR; PG8_MMA(1, 1, At, B1); PG8_BAR;
            PG8_LDB(B0, 1, 0); PG8_SCHED; PG8_LDA(At, 1, 0); PG8_STAGE(PG8_SA(0, 1), a2 + hstep, voffA);
            PG8_WAIT_L(8); PG8_BAR; PG8_WAIT_L(0); PG8_MMA(0, 0, At, B0); PG8_BAR; PG8_SCHED;
            PG8_LDB(B1, 1, 1); PG8_STAGE(PG8_SB(1, 0), b3, voffB);
            PG8_BAR; PG8_WAIT_L(0); PG8_MMA(0, 1, At, B1); PG8_BAR;
            PG8_LDA(At, 1, 1); PG8_STAGE(PG8_SA(1, 0), a3, voffA);
            PG8_BAR; PG8_WAIT_L(0); PG8_MMA(1, 0, At, B0); PG8_BAR; PG8_SCHED;
            PG8_STAGE(PG8_SB(1, 1), b3 + hstep, voffB);
            PG8_WAIT_V(6); PG8_BAR; PG8_MMA(1, 1, At, B1); PG8_BAR;
            }
        }
        if constexpr (ALIGN_EPI) { if (wr == 0) PG8_BAR; }
        if constexpr (!Epi::AFTER_DRAIN) { E(acc, cur, wr, wc, fr, fq); S.done(cur); }
        if (!has_next) break;
#pragma unroll
        for (int a = 0; a < 2; ++a)
#pragma unroll
            for (int b = 0; b < 2; ++b)
#pragma unroll
                for (int m = 0; m < 4; ++m)
#pragma unroll
                    for (int n = 0; n < 2; ++n) acc[a][b][m][n] = (f32x4){0.f, 0.f, 0.f, 0.f};
        cur = nxt; cA = nA; cB = nB; ++ui;
        if constexpr (ALIGN_EPI) { if (wr == 1) PG8_BAR; }
    }
    PG8_WAIT_V(0);
    if constexpr (!ALIGN_EPI) { if (wr == 0) PG8_BAR; }
    PG8_BAR;
    if constexpr (Epi::AFTER_DRAIN) { E.fused(acc, cur, wr, wc, fr, fq, lds, wid, lane); S.done(cur); }
#undef PG8_SA
#undef PG8_SB
#undef PG8_STAGE
#undef PG8_LDA
#undef PG8_LDB
#undef PG8_MMA
#undef PG8_WAIT_V
#undef PG8_WAIT_L
#undef PG8_BAR
#undef PG8_SCHED
}
}
#define LAS __attribute__((address_space(3)))
typedef unsigned short bf16_t;
typedef short bf16x8 __attribute__((ext_vector_type(8)));
typedef float f32x4 __attribute__((ext_vector_type(4)));
typedef float f32x16 __attribute__((ext_vector_type(16)));
typedef unsigned u32x4 __attribute__((ext_vector_type(4)));
typedef unsigned u32x2 __attribute__((ext_vector_type(2)));
constexpr int DM = 1024, NBATCH = 16, SEQ = 2048, MF = NBATCH * SEQ;
constexpr int HM = MF;
constexpr int KM = MF;
constexpr int VP = MF + 64;
constexpr size_t BUF_ELEMS = (size_t)33792 * 1024;
constexpr int PADR = 48, NMETA = 16;
constexpr float EPS = 1e-6f;
constexpr float QSCALE = 0.125f * 1.4426950408889634f;
constexpr size_t MiB = 1u << 20;
constexpr size_t WS_WAIN = 0, WS_WAOUT = 16 * MiB, WS_WKQZ = 20 * MiB, WS_WVT = 26 * MiB, WS_WQZ1 = 28 * MiB, WS_WBOUT = 32 * MiB, WS_SS = 36 * MiB, WS_CTL = 39 * MiB,
                 WS_HB = 40 * MiB, WS_BUF0 = 106 * MiB, WS_BUF1 = 172 * MiB, WS_BUF2 = 238 * MiB, WS_BUF3 = 304 * MiB, WS_BUF4 = 370 * MiB, WS_END = 436 * MiB;
constexpr int LDS_BYTES = 135168;

using pg8::cvt_pk_bf16;
__device__ __forceinline__ float bf_lo(unsigned w) { return __uint_as_float(w << 16); }
__device__ __forceinline__ float bf_hi(unsigned w) { return __uint_as_float(w & 0xffff0000u); }
__device__ __forceinline__ float fast_exp2(float x) { return __builtin_amdgcn_exp2f(x); }
__device__ __forceinline__ float silu_f(float z) { return z * __builtin_amdgcn_rcpf(1.0f + fast_exp2(-1.4426950408889634f * z)); }
__device__ __forceinline__ float wave_sum(float v) {
#pragma unroll
    for (int o = 1; o < 64; o <<= 1) v += __shfl_xor(v, o);
    return v;
}
__device__ __forceinline__ float row_rstd(const float* part, int row, int fq) {
    const f32x4 p = *(const f32x4*)(part + (size_t)row * 16 + 4 * fq);
    float s = (p[0] + p[1]) + (p[2] + p[3]);
    s += __shfl_xor(s, 16); s += __shfl_xor(s, 32);
    return rsqrtf(s * (1.0f / DM) + EPS);
}

__device__ __forceinline__ f32x4 rstd_load(const float* part, int row, int fq) { return *(const f32x4*)(part + (size_t)row * 16 + 4 * fq); }
__device__ __forceinline__ float rstd_reduce(const f32x4 p) {
    float s = (p[0] + p[1]) + (p[2] + p[3]);
    s += __shfl_xor(s, 16); s += __shfl_xor(s, 32);
    return rsqrtf(s * (1.0f / DM) + EPS);
}
__device__ __forceinline__ float dpp_ror1(float x) { return __int_as_float(__builtin_amdgcn_update_dpp(0, __float_as_int(x), 0x121, 0xF, 0xF, false)); }
__device__ __forceinline__ float dpp_ror2(float x) { return __int_as_float(__builtin_amdgcn_update_dpp(0, __float_as_int(x), 0x122, 0xF, 0xF, false)); }
struct EpiAIn {
    static constexpr bool PERM = false, AFTER_DRAIN = false;
    const float* part; bf16_t* vbuf; bf16_t* gzbuf; bf16_t* ybuf; const float* cw; const float* cb;
    __device__ __forceinline__ void operator()(const f32x4 (&acc)[2][2][4][2], const pg8::Unit& u, int wr, int wc, int fr, int fq) const {
        const int ch0 = 64 * u.pn + 16 * wc + 4 * fq;
        const f32x4 w0 = *(const f32x4*)(cw + ch0), w1 = *(const f32x4*)(cw + DM + ch0), w2 = *(const f32x4*)(cw + 2 * DM + ch0), bb = *(const f32x4*)(cb + ch0);
        f32x4 pp[2][4];
#pragma unroll
        for (int ai = 0; ai < 2; ++ai)
#pragma unroll
            for (int m = 0; m < 4; ++m) pp[ai][m] = rstd_load(part, u.pm * 256 + ai * 128 + wr * 64 + m * 16 + fr, fq);
#pragma unroll
        for (int ai = 0; ai < 2; ++ai) {
            f32x4 vprev = (f32x4){0.f, 0.f, 0.f, 0.f};
#pragma unroll
            for (int m = 0; m < 4; ++m) {
                const int row = u.pm * 256 + ai * 128 + wr * 64 + m * 16 + fr;
                const float rs = rstd_reduce(pp[ai][m]);
                const f32x4 b = acc[ai][0][m][0] * rs, c = acc[ai][0][m][1] * rs, hin = acc[ai][1][m][0] * rs, z = acc[ai][1][m][1] * rs;
                const f32x4 v = c * hin;
                f32x4 gz, y;
#pragma unroll
                for (int j = 0; j < 4; ++j) {
                    gz[j] = b[j] * silu_f(z[j]);
                    const float r1c = dpp_ror1(v[j]), r2c = dpp_ror2(v[j]), r1p = dpp_ror1(vprev[j]), r2p = dpp_ror2(vprev[j]);
                    const float p1 = (fr >= 1) ? r1c : r1p, p2 = (fr >= 2) ? r2c : r2p;
                    y[j] = gz[j] * (w0[j] * p2 + w1[j] * p1 + w2[j] * v[j] + bb[j]);
                }
                const size_t o = (size_t)row * DM + ch0;
                if (m == 0 && fr < 2) {
                    u32x2 wv, wg; wv.x = cvt_pk_bf16(v[0], v[1]); wv.y = cvt_pk_bf16(v[2], v[3]); wg.x = cvt_pk_bf16(gz[0], gz[1]); wg.y = cvt_pk_bf16(gz[2], gz[3]);
                    *(u32x2*)(vbuf + o) = wv; *(u32x2*)(gzbuf + o) = wg;
                } else {
                    u32x2 wy; wy.x = cvt_pk_bf16(y[0], y[1]); wy.y = cvt_pk_bf16(y[2], y[3]);
                    *(u32x2*)(ybuf + o) = wy;
                    if (m == 3 && fr >= 14) { u32x2 wv; wv.x = cvt_pk_bf16(v[0], v[1]); wv.y = cvt_pk_bf16(v[2], v[3]); *(u32x2*)(vbuf + o) = wv; }
                }
                vprev = v;
            }
        }
    }
};
struct EpiRes {
    static constexpr bool PERM = true, AFTER_DRAIN = false;
    bf16_t* hb; float* part;
    __device__ __forceinline__ void operator()(const f32x4 (&acc)[2][2][4][2], const pg8::Unit& u, int wr, int wc, int fr, int fq) const {
        u32x4 old[2][4][2];
#pragma unroll
        for (int ai = 0; ai < 2; ++ai)
#pragma unroll
            for (int m = 0; m < 4; ++m)
#pragma unroll
                for (int bj = 0; bj < 2; ++bj)
                    old[ai][m][bj] = *(const u32x4*)(hb + (size_t)(u.pm * 256 + ai * 128 + wr * 64 + m * 16 + fr) * DM + u.pn * 256 + bj * 128 + wc * 32 + 8 * fq);
#pragma unroll
        for (int ai = 0; ai < 2; ++ai)
#pragma unroll
            for (int m = 0; m < 4; ++m) {
                const int row = u.pm * 256 + ai * 128 + wr * 64 + m * 16 + fr;
                float ssq = 0.f;
#pragma unroll
                for (int bj = 0; bj < 2; ++bj) {
                    bf16_t* p = hb + (size_t)row * DM + u.pn * 256 + bj * 128 + wc * 32 + 8 * fq;
                    const u32x4 o4 = old[ai][m][bj];
                    const f32x4 a0 = acc[ai][bj][m][0], a1 = acc[ai][bj][m][1];
                    float v[8];
                    v[0] = bf_lo(o4.x) + a0[0]; v[1] = bf_hi(o4.x) + a0[1]; v[2] = bf_lo(o4.y) + a0[2]; v[3] = bf_hi(o4.y) + a0[3];
                    v[4] = bf_lo(o4.z) + a1[0]; v[5] = bf_hi(o4.z) + a1[1]; v[6] = bf_lo(o4.w) + a1[2]; v[7] = bf_hi(o4.w) + a1[3];
#pragma unroll
                    for (int i = 0; i < 8; ++i) ssq += v[i] * v[i];
                    u32x4 w; w.x = cvt_pk_bf16(v[0], v[1]); w.y = cvt_pk_bf16(v[2], v[3]); w.z = cvt_pk_bf16(v[4], v[5]); w.w = cvt_pk_bf16(v[6], v[7]);
                    *(u32x4*)p = w;
                }
                ssq += __shfl_xor(ssq, 16); ssq += __shfl_xor(ssq, 32);
                if (fq == 0) part[(size_t)row * 16 + 4 * u.pn + wc] = ssq;
            }
    }
};
struct EpiKQZ {
    static constexpr bool PERM = true, AFTER_DRAIN = false;
    const float* part; bf16_t* kqz; int tbase;
    __device__ __forceinline__ void operator()(const f32x4 (&acc)[2][2][4][2], const pg8::Unit& u, int wr, int wc, int fr, int fq) const {
        const int t = (u.pn >> 2) + tbase;
        bf16_t* dst = kqz + (size_t)t * BUF_ELEMS;
        const float sc = (t == 1) ? QSCALE : 1.0f;
        const int col0 = (u.pn & 3) * 256 + wc * 32 + 8 * fq;
        f32x4 pp[2][4];
#pragma unroll
        for (int ai = 0; ai < 2; ++ai)
#pragma unroll
            for (int m = 0; m < 4; ++m) pp[ai][m] = rstd_load(part, u.pm * 256 + ai * 128 + wr * 64 + m * 16 + fr, fq);
#pragma unroll
        for (int ai = 0; ai < 2; ++ai)
#pragma unroll
            for (int m = 0; m < 4; ++m) {
                const int row = u.pm * 256 + ai * 128 + wr * 64 + m * 16 + fr;
                const float rs = rstd_reduce(pp[ai][m]) * sc;
#pragma unroll
                for (int bj = 0; bj < 2; ++bj) {
                    f32x4 a0 = acc[ai][bj][m][0] * rs, a1 = acc[ai][bj][m][1] * rs;
                    if (t == 2) {
#pragma unroll
                        for (int j = 0; j < 4; ++j) { a0[j] = silu_f(a0[j]); a1[j] = silu_f(a1[j]); }
                    }
                    u32x4 w; w.x = cvt_pk_bf16(a0[0], a0[1]); w.y = cvt_pk_bf16(a0[2], a0[3]); w.z = cvt_pk_bf16(a1[0], a1[1]); w.w = cvt_pk_bf16(a1[2], a1[3]);
                    *(u32x4*)(dst + (size_t)row * DM + col0 + bj * 128) = w;
                }
            }
    }
};
struct EpiVt {
    static constexpr bool PERM = true, AFTER_DRAIN = false;
    const float* part; bf16_t* vt;
    __device__ __forceinline__ void operator()(const f32x4 (&acc)[2][2][4][2], const pg8::Unit& u, int wr, int wc, int fr, int fq) const {
        const int lane = fr + 16 * fq;
        float rsl;
        { const int tok = u.pn * 256 + 128 * (lane >> 5) + 32 * wc + (lane & 31);
          const f32x4* p = (const f32x4*)(part + (size_t)tok * 16);
          const f32x4 p0 = p[0], p1 = p[1], p2 = p[2], p3 = p[3];
          const float s = ((p0[0] + p0[1]) + (p0[2] + p0[3])) + ((p1[0] + p1[1]) + (p1[2] + p1[3])) + ((p2[0] + p2[1]) + (p2[2] + p2[3])) + ((p3[0] + p3[1]) + (p3[2] + p3[3]));
          rsl = rsqrtf(s * (1.0f / DM) + EPS); }
        float rs[2][8];
#pragma unroll
        for (int bj = 0; bj < 2; ++bj)
#pragma unroll
            for (int i = 0; i < 8; ++i) rs[bj][i] = __shfl(rsl, 32 * bj + 8 * fq + i);
#pragma unroll
        for (int ai = 0; ai < 2; ++ai)
#pragma unroll
            for (int m = 0; m < 4; ++m) {
                const int e = u.pm * 256 + ai * 128 + wr * 64 + m * 16 + fr;
#pragma unroll
                for (int bj = 0; bj < 2; ++bj)
#pragma unroll
                    for (int n = 0; n < 2; ++n) {
                        const f32x4 a = acc[ai][bj][m][n];
                        u32x2 w; w.x = cvt_pk_bf16(a[0] * rs[bj][4 * n + 0], a[1] * rs[bj][4 * n + 1]); w.y = cvt_pk_bf16(a[2] * rs[bj][4 * n + 2], a[3] * rs[bj][4 * n + 3]);
                        *(u32x2*)(vt + (size_t)e * VP + u.pn * 256 + bj * 128 + wc * 32 + 16 * (fq >> 1) + 8 * n + 4 * (fq & 1)) = w;
                    }
            }
    }
};

__device__ __forceinline__ void mini_gemm4(const bf16_t* __restrict__ A, const bf16_t* __restrict__ w0, const bf16_t* __restrict__ w1, const bf16_t* __restrict__ w2, const bf16_t* __restrict__ w3, f32x4 (&acc)[4], int wave, int lane, LAS unsigned char* lds) {
    const int off = (lane & 15) * DM + (lane >> 4) * 8 + wave * 128;
    const bf16_t* ap = A + off; const bf16_t* p0 = w0 + off; const bf16_t* p1 = w1 + off; const bf16_t* p2 = w2 + off; const bf16_t* p3 = w3 + off;
    bf16x8 bv[4], a0[4], a1[4], a2[4], a3[4];
#pragma unroll
    for (int kk = 0; kk < 4; ++kk) { bv[kk] = *(const bf16x8*)(ap + kk * 32); a0[kk] = *(const bf16x8*)(p0 + kk * 32); a1[kk] = *(const bf16x8*)(p1 + kk * 32); a2[kk] = *(const bf16x8*)(p2 + kk * 32); a3[kk] = *(const bf16x8*)(p3 + kk * 32); }
#pragma unroll
    for (int i = 0; i < 4; ++i) acc[i] = (f32x4){0.f, 0.f, 0.f, 0.f};
#pragma unroll
    for (int kk = 0; kk < 4; ++kk) {
        acc[0] = __builtin_amdgcn_mfma_f32_16x16x32_bf16(a0[kk], bv[kk], acc[0], 0, 0, 0); acc[1] = __builtin_amdgcn_mfma_f32_16x16x32_bf16(a1[kk], bv[kk], acc[1], 0, 0, 0);
        acc[2] = __builtin_amdgcn_mfma_f32_16x16x32_bf16(a2[kk], bv[kk], acc[2], 0, 0, 0); acc[3] = __builtin_amdgcn_mfma_f32_16x16x32_bf16(a3[kk], bv[kk], acc[3], 0, 0, 0);
    }
    LAS f32x4* red = (LAS f32x4*)lds;
#pragma unroll
    for (int i = 0; i < 4; ++i) red[(wave * 4 + i) * 64 + lane] = acc[i];
    __syncthreads();
    if (wave == 0) {
#pragma unroll
        for (int w = 1; w < 8; ++w)
#pragma unroll
            for (int i = 0; i < 4; ++i) acc[i] += red[(w * 4 + i) * 64 + lane];
    }
    __syncthreads();
}
__device__ __forceinline__ float meta_rstd(const float* part, int m) {
    const f32x4* p = (const f32x4*)(part + (size_t)(HM + m) * 16);
    const f32x4 p0 = p[0], p1 = p[1], p2 = p[2], p3 = p[3];
    const float s = ((p0[0] + p0[1]) + (p0[2] + p0[3])) + ((p1[0] + p1[1]) + (p1[2] + p1[3])) + ((p2[0] + p2[1]) + (p2[2] + p2[3])) + ((p3[0] + p3[1]) + (p3[2] + p3[3]));
    return rsqrtf(s * (1.0f / DM) + EPS);
}
__device__ __forceinline__ void meta_ain_job(int j, const bf16_t* hb, const bf16_t* W, const float* part, bf16_t* vbuf, bf16_t* gzbuf, int wave, int lane, LAS unsigned char* lds) {
    const int pn = j >> 2, wc = j & 3, fr = lane & 15, fq = lane >> 4;
    const bf16_t* wb = W + (size_t)(256 * pn + 32 * wc) * DM;
    f32x4 acc[4];
    mini_gemm4(hb + (size_t)HM * DM, wb, wb + 16 * DM, wb + 128 * DM, wb + 144 * DM, acc, wave, lane, lds);
    if (wave != 0) return;
    const float rs = meta_rstd(part, fr);
    const f32x4 bb = acc[0] * rs, c = acc[1] * rs, hin = acc[2] * rs, z = acc[3] * rs;
    const f32x4 v = c * hin; f32x4 gz;
#pragma unroll
    for (int q = 0; q < 4; ++q) gz[q] = bb[q] * silu_f(z[q]);
    u32x2 wv, wg; wv.x = cvt_pk_bf16(v[0], v[1]); wv.y = cvt_pk_bf16(v[2], v[3]); wg.x = cvt_pk_bf16(gz[0], gz[1]); wg.y = cvt_pk_bf16(gz[2], gz[3]);
    const size_t o = (size_t)(HM + fr) * DM + 64 * pn + 16 * wc + 4 * fq;
    *(u32x2*)(vbuf + o) = wv; *(u32x2*)(gzbuf + o) = wg;
}
__device__ __forceinline__ void meta_res_job(int j, const bf16_t* A, const bf16_t* W, bf16_t* hb, float* part, int wave, int lane, LAS unsigned char* lds) {
    const int fr = lane & 15, fq = lane >> 4;
    const bf16_t* wb = W + (size_t)(64 * j) * DM;
    f32x4 acc[4];
    mini_gemm4(A + (size_t)HM * DM, wb, wb + 16 * DM, wb + 32 * DM, wb + 48 * DM, acc, wave, lane, lds);
    if (wave != 0) return;
    float ssq = 0.f;
#pragma unroll
    for (int i = 0; i < 4; ++i) {
        bf16_t* p = hb + (size_t)(HM + fr) * DM + 64 * j + 16 * i + 4 * fq;
        const u32x2 old = *(const u32x2*)p;
        const float v0 = bf_lo(old.x) + acc[i][0], v1 = bf_hi(old.x) + acc[i][1], v2 = bf_lo(old.y) + acc[i][2], v3 = bf_hi(old.y) + acc[i][3];
        ssq += (v0 * v0 + v1 * v1) + (v2 * v2 + v3 * v3);
        u32x2 w; w.x = cvt_pk_bf16(v0, v1); w.y = cvt_pk_bf16(v2, v3); *(u32x2*)p = w;
    }
    ssq += __shfl_xor(ssq, 16); ssq += __shfl_xor(ssq, 32);
    if (fq == 0) part[(size_t)(HM + fr) * 16 + j] = ssq;
}
__device__ __forceinline__ void meta_k_job(int j, const bf16_t* hb, const bf16_t* W, const float* part, bf16_t* kb, int wave, int lane, LAS unsigned char* lds) {
    const int fr = lane & 15, fq = lane >> 4;
    const bf16_t* wb = W + (size_t)(64 * j) * DM;
    f32x4 acc[4];
    mini_gemm4(hb + (size_t)HM * DM, wb, wb + 16 * DM, wb + 32 * DM, wb + 48 * DM, acc, wave, lane, lds);
    if (wave != 0) return;
    const float rs = meta_rstd(part, fr);
#pragma unroll
    for (int i = 0; i < 4; ++i) { const f32x4 a = acc[i] * rs; u32x2 w; w.x = cvt_pk_bf16(a[0], a[1]); w.y = cvt_pk_bf16(a[2], a[3]);
        *(u32x2*)(kb + (size_t)(KM + PADR + fr) * DM + 64 * j + 16 * i + 4 * fq) = w; }
}
__device__ __forceinline__ void meta_v_job(int j, const bf16_t* hb, const bf16_t* Wv, const float* part, bf16_t* vt, int wave, int lane, LAS unsigned char* lds) {
    const int fr = lane & 15, fq = lane >> 4;
    const bf16_t* wb = Wv + (size_t)(64 * j) * DM;
    f32x4 acc[4];
    mini_gemm4(hb + (size_t)HM * DM, wb, wb + 16 * DM, wb + 32 * DM, wb + 48 * DM, acc, wave, lane, lds);
    if (wave != 0) return;
    const float rs = meta_rstd(part, fr);
    const int pos = 8 * ((fr >> 2) & 1) + 4 * (fr >> 3) + (fr & 3);
#pragma unroll
    for (int i = 0; i < 4; ++i)
#pragma unroll
        for (int r = 0; r < 4; ++r) { const int e = 64 * j + 16 * i + 4 * fq + r; vt[(size_t)e * VP + MF + PADR + pos] = (bf16_t)(cvt_pk_bf16(acc[i][r] * rs, 0.f) & 0xffffu); }
}
#define XB_TMO      128
#define XB_XCNT(j)  (256  + 64 * (j))
#define XB_XSUB(j)  (1280 + 64 * (j))
#define XB_XGEN(j)  (2304 + 64 * (j))
#define XB_TOP      3328
#define XB_TOPGEN   3392
#define XCD_BAR_WORDS 3456
#define XB_SPIN_CAP (1u << 18)

__device__ __forceinline__ unsigned xb_ld(unsigned* p)              { return __hip_atomic_load(p, __ATOMIC_RELAXED, __HIP_MEMORY_SCOPE_AGENT); }
__device__ __forceinline__ unsigned xb_add(unsigned* p, unsigned v) { return __hip_atomic_fetch_add(p, v, __ATOMIC_RELAXED, __HIP_MEMORY_SCOPE_AGENT); }
__device__ __forceinline__ unsigned xb_xcc_id() { return (unsigned)__builtin_amdgcn_s_getreg((3 << 11) | 20) & 0xFu; }
#define XB_SPIN(cond, bar) do { unsigned _sp = 0; while (cond) { __builtin_amdgcn_s_sleep(1); \
    if ((++_sp & 255u) == 0u) { if (xb_ld(&(bar)[XB_TMO])) break; if (_sp > XB_SPIN_CAP) { atomicAdd(&(bar)[XB_TMO], 1u); break; } } } } while (0)

struct XcdBarrier {
    unsigned* bar; unsigned x;
    volatile LAS unsigned* st;
};

__device__ __forceinline__ XcdBarrier xcd_barrier_post(unsigned* bar, volatile LAS unsigned* st) {
    XcdBarrier b; b.bar = bar; b.x = xb_xcc_id(); b.st = st;
    if (threadIdx.x == 0) (void)xb_add(&bar[XB_XCNT(b.x)], 1u);
    return b;
}
__device__ __forceinline__ void xcd_barrier_complete(unsigned* bar, unsigned x, unsigned& nloc, unsigned& nx) {
    const unsigned G = gridDim.x * gridDim.y * gridDim.z;
    unsigned sum, cnt, mine, sp = 0u;
    for (;;) {
        sum = 0u; cnt = 0u; mine = 0u;
#pragma unroll
        for (unsigned j = 0; j < 16; ++j) { const unsigned c = xb_ld(&bar[XB_XCNT(j)]); sum += c; cnt += (c > 0u) ? 1u : 0u; mine = (j == x) ? c : mine; }
        if (sum == G) break;
        __builtin_amdgcn_s_sleep(1);
        if ((++sp & 255u) == 0u) { if (xb_ld(&bar[XB_TMO])) break; if (sp > XB_SPIN_CAP) { atomicAdd(&bar[XB_TMO], 1u); break; } }
    }
    nloc = mine > 0u ? mine : 1u; nx = cnt > 0u ? cnt : 1u;
}

__device__ __forceinline__ void xcd_barrier(const XcdBarrier& b) {
    asm volatile("s_waitcnt vmcnt(0)" ::: "memory");
    __syncthreads();
    if (threadIdx.x == 0) {
        unsigned* bar = b.bar;
        __builtin_amdgcn_s_waitcnt(0);
        unsigned nloc = b.st[0], nx = b.st[1];
        if (nloc == 0u) { xcd_barrier_complete(bar, b.x, nloc, nx); b.st[0] = nloc; b.st[1] = nx; }
        const unsigned old = xb_add(&bar[XB_XSUB(b.x)], 1u);
        const unsigned gen = old / nloc;
        if (old + 1u == (gen + 1u) * nloc) {
            __builtin_amdgcn_fence(__ATOMIC_RELEASE, "agent");
            asm volatile("s_waitcnt vmcnt(0)" ::: "memory");
            const unsigned og = xb_add(&bar[XB_TOP], 1u);
            const unsigned tg = og / nx;
            if (og + 1u == (tg + 1u) * nx) xb_add(&bar[XB_TOPGEN], 1u);
            else XB_SPIN(xb_ld(&bar[XB_TOPGEN]) == tg, bar);
            __builtin_amdgcn_fence(__ATOMIC_ACQUIRE, "agent");
            xb_add(&bar[XB_XGEN(b.x)], 1u);
            asm volatile("s_waitcnt vmcnt(0)" ::: "memory");
        } else {
            XB_SPIN(xb_ld(&bar[XB_XGEN(b.x)]) == gen, bar);
            __builtin_amdgcn_fence(__ATOMIC_ACQUIRE, "agent");
            asm volatile("s_waitcnt vmcnt(0)" ::: "memory");
        }
    }
    __syncthreads();
}
__device__ __forceinline__ int crow(int r, int hi) { return (r & 3) + 8 * (r >> 2) + 4 * hi; }
#define ATT_BAR() asm volatile("s_waitcnt lgkmcnt(0)\n\ts_barrier" ::: "memory")
__device__ __forceinline__ void att_wait_vm(int n) {
    if (n >= 8) asm volatile("s_waitcnt vmcnt(8)" ::: "memory"); else if (n == 6) asm volatile("s_waitcnt vmcnt(6)" ::: "memory");
    else if (n == 4) asm volatile("s_waitcnt vmcnt(4)" ::: "memory"); else if (n == 2) asm volatile("s_waitcnt vmcnt(2)" ::: "memory"); else asm volatile("s_waitcnt vmcnt(0)" ::: "memory");
}
constexpr float ATT_THR = 12.0f;
constexpr int ATT_VRING = 65536, ATT_XSTRIDE = 17408;
__device__ __forceinline__ void attn_unit(LAS unsigned char* lds, const bf16_t* Qb, const bf16_t* __restrict__ Kb, const bf16_t* __restrict__ Vt, const bf16_t* __restrict__ Zs,
                                          bf16_t* Ob  , const float* __restrict__ subg, float lam, float oml, int b, int h, int j) {
    int tid = threadIdx.x; asm volatile("" : "+v"(tid));
    const int lane = tid & 63, wid = __builtin_amdgcn_readfirstlane(tid >> 6), sub = wid & 3, map = wid >> 2, r32 = lane & 31, hi = lane >> 5;
    const size_t rowbase = (size_t)b * SEQ, qbase = rowbase + 128 * j;
    const int NT = 2 * j + 3, tmax = 2 * j + 1 + (sub >> 1);
    const bool active = true;
    bf16x8 qf[4];
    { const bf16_t* qsrc = Qb + (qbase + 32 * sub + r32) * DM + h * 128 + map * 64 + hi * 8;
#pragma unroll
      for (int ks = 0; ks < 4; ++ks) qf[ks] = __builtin_nontemporal_load((const bf16x8*)(qsrc + 16 * ks)); }
    const int prow = lane >> 3, pc = lane & 7;
    const int krow = 8 * wid + prow;
    const unsigned koff = (unsigned)(krow * DM + ((pc ^ ((krow >> 1) & 7)) << 3)) * 2u;
    const int vrow0 = 16 * wid + prow, vrow1 = vrow0 + 8;
    const unsigned voff0 = (unsigned)(vrow0 * VP + ((pc ^ ((vrow0 >> 1) & 7)) << 3)) * 2u, voff1 = (unsigned)(vrow1 * VP + ((pc ^ ((vrow1 >> 1) & 7)) << 3)) * 2u;
    const char* kbase = (const char*)(Kb + h * 128);
    const char* vbase = (const char*)(Vt + (size_t)(h * 128) * VP);
#define DMA16(g, off) __builtin_amdgcn_global_load_lds((const unsigned*)(g), (LAS unsigned*)(lds + (off)), 16, 0, 0)
#define TILE_ROW0(t) ((t) == 0 ? (size_t)KM : rowbase + (size_t)((t) - 1) * 64)
#define DMA_K(t, slot) do { const char* kb_ = kbase + TILE_ROW0(t) * (DM * 2); DMA16(kb_ + koff, (slot) * 16384 + wid * 1024); DMA16(kb_ + 128 + koff, (slot) * 16384 + 8192 + wid * 1024); } while (0)
#define DMA_V(t, slot) do { const char* vb_ = vbase + TILE_ROW0(t) * 2; DMA16(vb_ + voff0, ATT_VRING + (slot) * 16384 + wid * 2048); DMA16(vb_ + voff1, ATT_VRING + (slot) * 16384 + wid * 2048 + 1024); } while (0)
    DMA_K(0, 0); DMA_V(0, 0); DMA_K(1, 1);
    const unsigned offk0 = (unsigned)(r32 * 128 + ((hi ^ ((r32 >> 1) & 7)) << 4));
#define OFFK(ks) (offk0 ^ (32u * (ks)))
    f32x16 o[4], s0, s1, negm;
#pragma unroll
    for (int r = 0; r < 16; ++r) { o[0][r] = 0.f; o[1][r] = 0.f; o[2][r] = 0.f; o[3][r] = 0.f; negm[r] = 0.f; }
    float mref = 0.f, lrun = 0.f;
    bf16x8 pf[4];
#define RD128(dst, addr, imm) asm volatile("ds_read_b128 %0, %1 offset:%c2" : "=&v"(dst) : "v"(addr), "i"(imm) : "memory")
#define LW4(n, X) asm volatile("s_waitcnt lgkmcnt(" #n ")" : "+v"(X[0]), "+v"(X[1]), "+v"(X[2]), "+v"(X[3]) :: "memory")
#define SB() __builtin_amdgcn_sched_barrier(0)
#define MF(a, b, c) __builtin_amdgcn_mfma_f32_32x32x16_bf16(a, b, c, 0, 0, 0)
    const unsigned ldsb = (unsigned)(uintptr_t)lds;
    bf16x8 gA[4], gB[4], gC[4];
#define RDV(G, va) do { RD128(G[0], va, 0); RD128(G[1], va, 4096); RD128(G[2], va, 8192); RD128(G[3], va, 12288); } while (0)
#define RDK(G, ka, c0, c1) do { RD128(G[0], ka + OFFK(c0), 0); RD128(G[1], ka + OFFK(c0), 4096); RD128(G[2], ka + OFFK(c1), 0); RD128(G[3], ka + OFFK(c1), 4096); } while (0)
#define PV4(G, p) do { o[0] = MF(G[0], p, o[0]); o[1] = MF(G[1], p, o[1]); o[2] = MF(G[2], p, o[2]); o[3] = MF(G[3], p, o[3]); SB(); } while (0)
#define ATT_S0() do { const unsigned ka_ = ldsb + map * 8192; \
        RDK(gA, ka_, 0, 1); RDK(gB, ka_, 2, 3); \
        LW4(4, gA); s0 = MF(gA[0], qf[0], negm); s1 = MF(gA[1], qf[0], negm); s0 = MF(gA[2], qf[1], s0); s1 = MF(gA[3], qf[1], s1); SB(); \
        LW4(0, gB); s0 = MF(gB[0], qf[2], s0); s1 = MF(gB[1], qf[2], s1); s0 = MF(gB[2], qf[3], s0); s1 = MF(gB[3], qf[3], s1); SB(); } while (0)
#define ATT_ISSUE(vslot) do { const unsigned vb_ = ldsb + ATT_VRING + (vslot) * 16384; \
        RDV(gA, vb_ + OFFK(0)); RDV(gB, vb_ + OFFK(1)); RDV(gC, vb_ + OFFK(2)); } while (0)
#define ATT_CONSUME(vslot, kslot, DO_S) do { const unsigned vb_ = ldsb + ATT_VRING + (vslot) * 16384, ka_ = ldsb + (kslot) * 16384 + map * 8192; \
        LW4(8, gA); PV4(gA, pf[0]); RDV(gA, vb_ + OFFK(3)); \
        if (DO_S) { \
            LW4(8, gB); PV4(gB, pf[1]); RDK(gB, ka_, 0, 1); \
            LW4(8, gC); PV4(gC, pf[2]); RDK(gC, ka_, 2, 3); \
            LW4(8, gA); PV4(gA, pf[3]); \
            LW4(4, gB); s0 = MF(gB[0], qf[0], negm); s1 = MF(gB[1], qf[0], negm); s0 = MF(gB[2], qf[1], s0); s1 = MF(gB[3], qf[1], s1); SB(); \
            LW4(0, gC); s0 = MF(gC[0], qf[2], s0); s1 = MF(gC[1], qf[2], s1); s0 = MF(gC[2], qf[3], s0); s1 = MF(gC[3], qf[3], s1); SB(); \
        } else { LW4(8, gB); PV4(gB, pf[1]); LW4(4, gC); PV4(gC, pf[2]); LW4(0, gA); PV4(gA, pf[3]); } } while (0)
#define MAX3(a, b, c) ({ float r_; asm("v_max3_f32 %0, %1, %2, %3" : "=v"(r_) : "v"(a), "v"(b), "v"(c)); r_; })
#define ATT_SOFTMAX(first) do { \
        asm volatile("s_nop 15\n\ts_nop 7" : "+v"(s0), "+v"(s1));                 \
        float ma_ = MAX3(s0[0], s0[1], s0[2]), mb_ = MAX3(s0[3], s0[4], s0[5]); \
        ma_ = MAX3(ma_, s0[6], s0[7]); mb_ = MAX3(mb_, s0[8], s0[9]); ma_ = MAX3(ma_, s0[10], s0[11]); mb_ = MAX3(mb_, s0[12], s0[13]); ma_ = MAX3(ma_, s0[14], s0[15]); \
        mb_ = MAX3(mb_, s1[0], s1[1]); ma_ = MAX3(ma_, s1[2], s1[3]); mb_ = MAX3(mb_, s1[4], s1[5]); ma_ = MAX3(ma_, s1[6], s1[7]); \
        mb_ = MAX3(mb_, s1[8], s1[9]); ma_ = MAX3(ma_, s1[10], s1[11]); mb_ = MAX3(mb_, s1[12], s1[13]); ma_ = MAX3(ma_, s1[14], s1[15]); \
        float mx_ = MAX3(ma_, mb_, mb_); \
        { auto rr_ = __builtin_amdgcn_permlane32_swap(__float_as_uint(mx_), __float_as_uint(mx_), false, false); const float x0_ = __uint_as_float(rr_[0]), x1_ = __uint_as_float(rr_[1]); mx_ = MAX3(x0_, x1_, x1_); } \
        if (first) { mref = mx_; \
            _Pragma("unroll") for (int r = 0; r < 16; ++r) { s0[r] -= mx_; s1[r] -= mx_; negm[r] = -mref; } } \
        else if (__any(mx_ > ATT_THR)) { \
            const float dl_ = (mx_ > 0.f) ? mx_ : 0.f; const float al_ = fast_exp2(-dl_); mref += dl_; lrun *= al_; \
            _Pragma("unroll") for (int r = 0; r < 16; ++r) { s0[r] -= dl_; s1[r] -= dl_; negm[r] = -mref; } \
            _Pragma("unroll") for (int eb = 0; eb < 4; ++eb) _Pragma("unroll") for (int r = 0; r < 16; ++r) o[eb][r] *= al_; } \
        float ls_ = 0.f; \
        _Pragma("unroll") for (int r = 0; r < 16; ++r) { s0[r] = fast_exp2(s0[r]); s1[r] = fast_exp2(s1[r]); ls_ += s0[r] + s1[r]; } \
        lrun += ls_; \
        _Pragma("unroll") for (int s = 0; s < 2; ++s) { u32x4 w_; \
            w_.x = cvt_pk_bf16(s0[8 * s + 0], s0[8 * s + 1]); w_.y = cvt_pk_bf16(s0[8 * s + 2], s0[8 * s + 3]); w_.z = cvt_pk_bf16(s0[8 * s + 4], s0[8 * s + 5]); w_.w = cvt_pk_bf16(s0[8 * s + 6], s0[8 * s + 7]); \
            pf[s] = __builtin_bit_cast(bf16x8, w_); \
            w_.x = cvt_pk_bf16(s1[8 * s + 0], s1[8 * s + 1]); w_.y = cvt_pk_bf16(s1[8 * s + 2], s1[8 * s + 3]); w_.z = cvt_pk_bf16(s1[8 * s + 4], s1[8 * s + 5]); w_.w = cvt_pk_bf16(s1[8 * s + 6], s1[8 * s + 7]); \
            pf[2 + s] = __builtin_bit_cast(bf16x8, w_); } } while (0)
#define ADDF(a, b) ({ float r_; asm("v_add_f32 %0, %1, %2" : "=v"(r_) : "v"(a), "v"(b)); r_; })
#define SUM8(X, b) ADDF(ADDF(ADDF(X[b], X[b + 1]), ADDF(X[b + 2], X[b + 3])), ADDF(ADDF(X[b + 4], X[b + 5]), ADDF(X[b + 6], X[b + 7])))
#define EX4(X, b) do { X[b] = fast_exp2(X[b]); X[b + 1] = fast_exp2(X[b + 1]); X[b + 2] = fast_exp2(X[b + 2]); X[b + 3] = fast_exp2(X[b + 3]); } while (0)
#define CV8(dst, X, b) do { u32x4 w_; w_.x = cvt_pk_bf16(X[b], X[b + 1]); w_.y = cvt_pk_bf16(X[b + 2], X[b + 3]); w_.z = cvt_pk_bf16(X[b + 4], X[b + 5]); w_.w = cvt_pk_bf16(X[b + 6], X[b + 7]); dst = __builtin_bit_cast(bf16x8, w_); } while (0)
#define ATT_UNI(vslot, kslot) do { const unsigned vb_ = ldsb + ATT_VRING + (vslot) * 16384, ka_ = ldsb + (kslot) * 16384 + map * 8192; \
        RDK(gA, ka_, 0, 1); RDK(gB, ka_, 2, 3); RDV(gC, vb_ + OFFK(0)); \
        __builtin_amdgcn_s_setprio(2); \
        LW4(8, gA); s0 = MF(gA[0], qf[0], negm); s1 = MF(gA[1], qf[0], negm); s0 = MF(gA[2], qf[1], s0); s1 = MF(gA[3], qf[1], s1); SB(); \
        RDV(gA, vb_ + OFFK(1)); \
        LW4(8, gB); s0 = MF(gB[0], qf[2], s0); s1 = MF(gB[1], qf[2], s1); s0 = MF(gB[2], qf[3], s0); s1 = MF(gB[3], qf[3], s1); SB(); \
        RDV(gB, vb_ + OFFK(2)); \
        __builtin_amdgcn_s_setprio(0); \
        LW4(8, gC); o[0] = MF(gC[0], pf[0], o[0]); o[1] = MF(gC[1], pf[0], o[1]); SB(); \
        asm volatile("s_nop 15\n\ts_nop 7" : "+v"(s0), "+v"(s1)); \
        float ma_ = MAX3(s0[0], s0[1], s0[2]), mb_ = MAX3(s0[3], s0[4], s0[5]); ma_ = MAX3(ma_, s0[6], s0[7]); mb_ = MAX3(mb_, s0[8], s0[9]); SB(); \
        o[2] = MF(gC[2], pf[0], o[2]); SB(); \
        ma_ = MAX3(ma_, s0[10], s0[11]); mb_ = MAX3(mb_, s0[12], s0[13]); ma_ = MAX3(ma_, s0[14], s0[15]); mb_ = MAX3(mb_, s1[0], s1[1]); ma_ = MAX3(ma_, s1[2], s1[3]); mb_ = MAX3(mb_, s1[4], s1[5]); SB(); \
        o[3] = MF(gC[3], pf[0], o[3]); SB(); \
        RDV(gC, vb_ + OFFK(3)); \
        ma_ = MAX3(ma_, s1[6], s1[7]); mb_ = MAX3(mb_, s1[8], s1[9]); ma_ = MAX3(ma_, s1[10], s1[11]); mb_ = MAX3(mb_, s1[12], s1[13]); ma_ = MAX3(ma_, s1[14], s1[15]); \
        float mx_ = MAX3(ma_, mb_, mb_); \
        { auto rr_ = __builtin_amdgcn_permlane32_swap(__float_as_uint(mx_), __float_as_uint(mx_), false, false); const float x0_ = __uint_as_float(rr_[0]), x1_ = __uint_as_float(rr_[1]); mx_ = MAX3(x0_, x1_, x1_); } \
        float alp_ = 1.0f; const bool resc_ = __any(mx_ > ATT_THR); \
        if (resc_) { const float dl_ = (mx_ > 0.f) ? mx_ : 0.f; alp_ = fast_exp2(-dl_); mref += dl_; lrun *= alp_; \
            _Pragma("unroll") for (int r = 0; r < 16; ++r) { s0[r] -= dl_; s1[r] -= dl_; negm[r] = -mref; } } \
        SB(); \
        LW4(8, gA); o[0] = MF(gA[0], pf[1], o[0]); SB(); EX4(s0, 0); SB(); o[1] = MF(gA[1], pf[1], o[1]); SB(); EX4(s0, 4); SB(); \
        o[2] = MF(gA[2], pf[1], o[2]); SB(); EX4(s0, 8); SB(); o[3] = MF(gA[3], pf[1], o[3]); SB(); EX4(s0, 12); SB(); \
        LW4(4, gB); o[0] = MF(gB[0], pf[2], o[0]); SB(); EX4(s1, 0); SB(); o[1] = MF(gB[1], pf[2], o[1]); SB(); EX4(s1, 4); SB(); \
        o[2] = MF(gB[2], pf[2], o[2]); SB(); EX4(s1, 8); SB(); o[3] = MF(gB[3], pf[2], o[3]); SB(); EX4(s1, 12); SB(); \
        bf16x8 pn0_, pn1_, pn2_, pn3_; float ls_; \
        LW4(0, gC); o[0] = MF(gC[0], pf[3], o[0]); SB(); \
        ls_ = SUM8(s0, 0); CV8(pn0_, s0, 0); SB(); \
        o[1] = MF(gC[1], pf[3], o[1]); SB(); \
        ls_ = ADDF(ls_, SUM8(s0, 8)); CV8(pn1_, s0, 8); SB(); \
        o[2] = MF(gC[2], pf[3], o[2]); SB(); \
        ls_ = ADDF(ls_, SUM8(s1, 0)); CV8(pn2_, s1, 0); SB(); \
        o[3] = MF(gC[3], pf[3], o[3]); SB(); \
        ls_ = ADDF(ls_, SUM8(s1, 8)); CV8(pn3_, s1, 8); SB(); \
        lrun += ls_; pf[0] = pn0_; pf[1] = pn1_; pf[2] = pn2_; pf[3] = pn3_; \
        if (resc_) { _Pragma("unroll") for (int eb = 0; eb < 4; ++eb) _Pragma("unroll") for (int r = 0; r < 16; ++r) o[eb][r] *= alp_; } } while (0)
    __builtin_amdgcn_s_waitcnt(0x0F74);
    ATT_BAR();
    if (active) {
        ATT_S0();
#pragma unroll
        for (int r = 0; r < 16; ++r) s0[r] = -INFINITY;
#pragma unroll
        for (int r = 0; r < 8; ++r) s1[r] = -INFINITY;
        DMA_V(1, 1); DMA_K(2, 2); DMA_V(2, 2); if (NT > 3) DMA_K(3, 3);
        ATT_SOFTMAX(true);
    }
    att_wait_vm(6 + (NT > 3 ? 2 : 0));
    int k3 = 0;
#define ATT_HEAD(k) ATT_BAR();                             \
        const int k3p1 = (k3 + 1) & 3; \
        if ((k) + 4 < NT) DMA_K((k) + 4, k3);              \
        if ((k) + 3 < NT) DMA_V((k) + 3, (k3 + 3) & 3);
#define ATT_TAIL(k) att_wait_vm(((k) + 4 < NT ? 2 : 0) + ((k) + 3 < NT ? 4 : 0) + ((k) + 2 < NT ? 2 : 0));     \
        k3 = k3p1;
    for (int k = 0; k < tmax; ++k) {
        ATT_HEAD(k)
        ATT_UNI(k3, k3p1);
        ATT_TAIL(k)
    }
    { ATT_HEAD(tmax)
      ATT_ISSUE(k3);
      ATT_CONSUME(k3, k3p1, false);
      ATT_TAIL(tmax) }
    if (tmax < NT - 1) { ATT_BAR(); att_wait_vm(0); }
#undef ATT_HEAD
#undef ATT_TAIL
#undef DMA16
#undef TILE_ROW0
#undef OFFK
#undef DMA_K
#undef DMA_V
#undef ATT_S0
#undef ATT_ISSUE
#undef ATT_CONSUME
#undef PV4
#undef RDV
#undef RDK
#undef RD128
#undef LW4
#undef SB
#undef MF
#undef ATT_SOFTMAX
#undef MAX3
#undef ATT_UNI
#undef EX4
#undef ADDF
#undef SUM8
#undef CV8
    { auto rr = __builtin_amdgcn_permlane32_swap(__float_as_uint(lrun), __float_as_uint(lrun), false, false); lrun = __uint_as_float(rr[0]) + __uint_as_float(rr[1]); }
    const float inv = 1.0f / lrun;
    LAS float* ex = (LAS float*)(lds + sub * ATT_XSTRIDE);
    const int e0 = (lane & 15) * 8;
    u32x4 zreg[8]; f32x4 ga, gb;
    if (map == 0) {
        ga = *(const f32x4*)(subg + e0); gb = *(const f32x4*)(subg + e0 + 4);
#pragma unroll
        for (int ps = 0; ps < 8; ++ps) zreg[ps] = __builtin_nontemporal_load((const u32x4*)(Zs + (qbase + 32 * sub + ps * 4 + (lane >> 4)) * DM + h * 128 + e0));
    }
    ATT_BAR();
    if (active && map == 1) {
        const float f = inv * lam;
#pragma unroll
        for (int eb = 0; eb < 4; ++eb)
#pragma unroll
            for (int rq = 0; rq < 4; ++rq) { f32x4 v; v[0] = o[eb][4 * rq] * f; v[1] = o[eb][4 * rq + 1] * f; v[2] = o[eb][4 * rq + 2] * f; v[3] = o[eb][4 * rq + 3] * f;
                *(LAS f32x4*)(ex + r32 * 132 + 32 * eb + 8 * rq + 4 * hi) = v; }
    }
    ATT_BAR();
    if (active && map == 0) {
        float ssq = 0.f;
#pragma unroll
        for (int eb = 0; eb < 4; ++eb)
#pragma unroll
            for (int rq = 0; rq < 4; ++rq) { const f32x4 x = *(const LAS f32x4*)(ex + r32 * 132 + 32 * eb + 8 * rq + 4 * hi);
#pragma unroll
                for (int j = 0; j < 4; ++j) { const float v = o[eb][4 * rq + j] * inv - x[j]; o[eb][4 * rq + j] = v; ssq += v * v; } }
        { auto rr = __builtin_amdgcn_permlane32_swap(__float_as_uint(ssq), __float_as_uint(ssq), false, false); ssq = __uint_as_float(rr[0]) + __uint_as_float(rr[1]); }
        const float rn = rsqrtf(ssq * (1.0f / 128.0f) + EPS) * oml;
#pragma unroll
        for (int eb = 0; eb < 4; ++eb)
#pragma unroll
            for (int rq = 0; rq < 4; ++rq) { f32x4 v; v[0] = o[eb][4 * rq] * rn; v[1] = o[eb][4 * rq + 1] * rn; v[2] = o[eb][4 * rq + 2] * rn; v[3] = o[eb][4 * rq + 3] * rn;
                *(LAS f32x4*)(ex + r32 * 132 + 32 * eb + 8 * rq + 4 * hi) = v; }
        asm volatile("s_waitcnt lgkmcnt(0)" ::: "memory");
#pragma unroll
        for (int ps = 0; ps < 8; ++ps) {
            const int q = ps * 4 + (lane >> 4);
            const size_t row = qbase + 32 * sub + q;
            const f32x4 xa = *(const LAS f32x4*)(ex + q * 132 + e0), xb = *(const LAS f32x4*)(ex + q * 132 + e0 + 4);
            const u32x4 z = zreg[ps];
            u32x4 w;
            w.x = cvt_pk_bf16(xa[0] * ga[0] * bf_lo(z.x), xa[1] * ga[1] * bf_hi(z.x)); w.y = cvt_pk_bf16(xa[2] * ga[2] * bf_lo(z.y), xa[3] * ga[3] * bf_hi(z.y));
            w.z = cvt_pk_bf16(xb[0] * gb[0] * bf_lo(z.z), xb[1] * gb[1] * bf_hi(z.z)); w.w = cvt_pk_bf16(xb[2] * gb[2] * bf_lo(z.w), xb[3] * gb[3] * bf_hi(z.w));
            *(u32x4*)(Ob + row * DM + h * 128 + e0) = w;
        }
    }
    ATT_BAR();
}
__device__ __forceinline__ void attn_phase(LAS unsigned char* lds, const bf16_t* Qb, const bf16_t* Kb, const bf16_t* Vt, const bf16_t* Zs, bf16_t* Ob, const float* subg, float lam, float oml, int vcu, int G) {
    for (int P = vcu; P < 1024; P += G) {
        const int bh = P >> 3, s = P & 7;
        for (int u = 0; u < 2; ++u) attn_unit(lds, Qb, Kb, Vt, Zs, Ob, subg, lam, oml, bh >> 3, bh & 7, u ? 15 - s : s);
    }
}
struct Args {
    const float *x, *meta, *a_norm_g, *a_w_in, *a_conv_w, *a_conv_b, *a_w_out, *kv_norm_g, *w_kv, *b_norm_g, *b_w_in, *lq1, *lk1, *lq2, *lk2, *subln_g, *b_w_out, *final_g;
    float* out; unsigned char* ws;
};
struct TrItem { const float* src; const float* g; bf16_t* dst; int N; };
__device__ __forceinline__ TrItem tr_decode(const Args& a, int it, int lane) {
    unsigned char* ws = a.ws;
    constexpr int I_AIN = 16 * 64, I_SQ = 16 * 16, I_BIN = 16 * 32;
    const float* W; const float* g; bf16_t* WT; int N, col_off = 0, row_off = 0, nblk; bool perma = false;
    int r = it;
    if (r < 2 * I_AIN) { const int l = r / I_AIN; r -= l * I_AIN; W = a.a_w_in + (size_t)l * DM * 4096; N = 4096; g = a.a_norm_g + l * DM; WT = (bf16_t*)(ws + WS_WAIN) + (size_t)l * 4096 * DM; nblk = 64; perma = true; }
    else { r -= 2 * I_AIN;
    if (r < 2 * I_SQ) { const int l = r / I_SQ; r -= l * I_SQ; W = a.a_w_out + (size_t)l * DM * DM; N = DM; g = nullptr; WT = (bf16_t*)(ws + WS_WAOUT) + (size_t)l * DM * DM; nblk = 16; }
    else { r -= 2 * I_SQ;
    if (r < I_SQ) { W = a.w_kv; N = 2048; g = a.kv_norm_g; WT = (bf16_t*)(ws + WS_WKQZ); nblk = 16; }
    else { r -= I_SQ;
    if (r < I_SQ) { W = a.w_kv; N = 2048; col_off = 1024; g = a.kv_norm_g; WT = (bf16_t*)(ws + WS_WVT); nblk = 16; }
    else { r -= I_SQ;
    if (r < I_BIN) { W = a.b_w_in; N = 2048; g = a.b_norm_g; WT = (bf16_t*)(ws + WS_WKQZ); row_off = 1024; nblk = 32; }
    else { r -= I_BIN;
    if (r < I_BIN) { W = a.b_w_in + (size_t)DM * 2048; N = 2048; g = a.b_norm_g + DM; WT = (bf16_t*)(ws + WS_WQZ1); nblk = 32; }
    else { r -= I_BIN; const int l = r / I_SQ; r -= l * I_SQ; W = a.b_w_out + (size_t)l * DM * DM; N = DM; g = nullptr; WT = (bf16_t*)(ws + WS_WBOUT) + (size_t)l * DM * DM; nblk = 16; } } } } } }
    const int kb = r / nblk, nb = r - kb * nblk, k0 = 64 * kb, n0 = 64 * nb, nq = lane & 15, kr = lane >> 4;
    const int np = n0 + 4 * nq; int src;
    if (perma) { const int pn = np >> 8, bj = (np >> 7) & 1, wc = (np >> 5) & 3, nn = (np >> 4) & 1, low = np & 15; src = (2 * bj + nn) * 1024 + 64 * pn + 16 * wc + low; }
    else src = col_off + np;
    TrItem t; t.src = W + (size_t)(k0 + kr) * N + src; t.g = g ? g + k0 : nullptr; t.dst = WT + (size_t)(row_off + n0) * DM + k0; t.N = N;
    return t;
}
__device__ __forceinline__ void tr_load(const TrItem& t, f32x4 (&v)[16]) {
#pragma unroll
    for (int i = 0; i < 16; ++i) v[i] = __builtin_nontemporal_load((const f32x4*)(t.src + (size_t)(4 * i) * t.N));
}
__device__ __forceinline__ void tr_store(const TrItem& t, const f32x4 (&v)[16], LAS float* scr, int lane) {
    const int nq = lane & 15, kr = lane >> 4;
#pragma unroll
    for (int i = 0; i < 16; ++i) { const int kk = 4 * i + kr; const float gg = t.g ? t.g[kk] : 1.0f;
        scr[kk * 65 + 4 * nq + 0] = v[i][0] * gg; scr[kk * 65 + 4 * nq + 1] = v[i][1] * gg; scr[kk * 65 + 4 * nq + 2] = v[i][2] * gg; scr[kk * 65 + 4 * nq + 3] = v[i][3] * gg; }
    asm volatile("s_waitcnt lgkmcnt(0)" ::: "memory");
    const int c = lane & 7;
#pragma unroll
    for (int j = 0; j < 8; ++j) { const int n = (lane >> 3) + 8 * j; const LAS float* s = scr + (8 * c) * 65 + n;
        u32x4 o; o.x = cvt_pk_bf16(s[0 * 65], s[1 * 65]); o.y = cvt_pk_bf16(s[2 * 65], s[3 * 65]); o.z = cvt_pk_bf16(s[4 * 65], s[5 * 65]); o.w = cvt_pk_bf16(s[6 * 65], s[7 * 65]);
        *(u32x4*)(t.dst + (size_t)n * DM + 8 * c) = o; }
    asm volatile("s_waitcnt lgkmcnt(0)" ::: "memory");
}
__device__ __forceinline__ void prologue(const Args& a, LAS unsigned char* lds, int gw, int NGW, int wave, int lane) {
    LAS float* scr = (LAS float*)(lds + wave * 16640);
    unsigned char* ws = a.ws;
    constexpr int NITEMS = 2 * (16 * 64) + 2 * 256 + 2 * 256 + 2 * (16 * 32) + 2 * 256;
    if (gw < NITEMS) {
        TrItem cur = tr_decode(a, gw, lane); f32x4 v[16]; tr_load(cur, v);
        for (int it = gw; it < NITEMS; it += NGW) {
            const bool more = it + NGW < NITEMS;
            TrItem nxt = cur; f32x4 vn[16];
            if (more) { nxt = tr_decode(a, it + NGW, lane); tr_load(nxt, vn); }
            tr_store(cur, v, scr, lane);
            if (more) { cur = nxt;
#pragma unroll
                for (int i = 0; i < 16; ++i) v[i] = vn[i]; }
        }
    }
    bf16_t* hb = (bf16_t*)(ws + WS_HB); float* part = (float*)(ws + WS_SS);
#define H0_LOAD(dst, r0) do { _Pragma("unroll") for (int q = 0; q < 4; ++q) { const int row_ = (r0) + q; const float* src_ = (row_ < MF) ? a.x + (size_t)row_ * DM : a.meta + (size_t)(row_ - MF) * DM; \
        _Pragma("unroll") for (int j = 0; j < 4; ++j) dst[q][j] = __builtin_nontemporal_load((const f32x4*)(src_ + 4 * lane + 256 * j)); } } while (0)
    if (gw * 4 < MF + NMETA) {
        f32x4 v[4][4]; H0_LOAD(v, gw * 4);
        for (int row0 = gw * 4; row0 < MF + NMETA; row0 += NGW * 4) {
            const bool more = row0 + NGW * 4 < MF + NMETA;
            f32x4 vn[4][4];
            if (more) H0_LOAD(vn, row0 + NGW * 4);
#pragma unroll
            for (int q = 0; q < 4; ++q) { const int row = row0 + q; float ss = 0.f;
#pragma unroll
                for (int j = 0; j < 4; ++j) { const f32x4 x = v[q][j];
                    ss += (x[0] * x[0] + x[1] * x[1]) + (x[2] * x[2] + x[3] * x[3]);
                    u32x2 w; w.x = cvt_pk_bf16(x[0], x[1]); w.y = cvt_pk_bf16(x[2], x[3]);
                    *(u32x2*)(hb + (size_t)row * DM + 4 * lane + 256 * j) = w; }
                ss = wave_sum(ss);
                if (lane < 16) part[(size_t)row * 16 + lane] = (lane == 0) ? ss : 0.f; }
            if (more) {
#pragma unroll
                for (int q = 0; q < 4; ++q)
#pragma unroll
                    for (int j = 0; j < 4; ++j) v[q][j] = vn[q][j]; }
        }
    }
#undef H0_LOAD
}
__device__ __forceinline__ void conv_phase(const bf16_t* __restrict__ v, const bf16_t* __restrict__ gz, bf16_t* __restrict__ y, const float* __restrict__ cw, const float* __restrict__ cb, int bid, int G, int tid) {
    const int cg8 = (tid & 127) * 8, rsub = tid >> 7;
    float w0[8], w1[8], w2[8], bb[8];
#pragma unroll
    for (int i = 0; i < 8; ++i) { w0[i] = cw[cg8 + i]; w1[i] = cw[DM + cg8 + i]; w2[i] = cw[2 * DM + cg8 + i]; bb[i] = cb[cg8 + i]; }
    for (int i = bid * 4 + rsub; i < MF / 32 + NMETA; i += G * 4) {
        const int r = (i < MF / 32) ? (i >> 1) * 64 + (i & 1) : MF + (i - MF / 32);
        int r1, r2;
        if (r < MF) { const int t = r & (SEQ - 1); r1 = (t >= 1) ? r - 1 : HM + 15; r2 = (t >= 2) ? r - 2 : HM + 14 + t; }
        else { const int mm = r - MF; r1 = (mm >= 1) ? r - 1 : -1; r2 = (mm >= 2) ? r - 2 : -1; }
        const u32x4 zero = (u32x4){0u, 0u, 0u, 0u};
        const u32x4 a0 = *(const u32x4*)(v + (size_t)r * DM + cg8);
        const u32x4 a1 = (r1 >= 0) ? *(const u32x4*)(v + (size_t)r1 * DM + cg8) : zero;
        const u32x4 a2 = (r2 >= 0) ? *(const u32x4*)(v + (size_t)r2 * DM + cg8) : zero;
        const u32x4 gg = *(const u32x4*)(gz + (size_t)r * DM + cg8);
        float o[8];
#pragma unroll
        for (int i = 0; i < 4; ++i) {
            const unsigned x0 = a0[i], x1 = a1[i], x2 = a2[i], gx = gg[i];
            o[2 * i] = bf_lo(gx) * (w0[2 * i] * bf_lo(x2) + w1[2 * i] * bf_lo(x1) + w2[2 * i] * bf_lo(x0) + bb[2 * i]);
            o[2 * i + 1] = bf_hi(gx) * (w0[2 * i + 1] * bf_hi(x2) + w1[2 * i + 1] * bf_hi(x1) + w2[2 * i + 1] * bf_hi(x0) + bb[2 * i + 1]);
        }
        u32x4 w; w.x = cvt_pk_bf16(o[0], o[1]); w.y = cvt_pk_bf16(o[2], o[3]); w.z = cvt_pk_bf16(o[4], o[5]); w.w = cvt_pk_bf16(o[6], o[7]);
        *(u32x4*)(y + (size_t)r * DM + cg8) = w;
    }
}
__device__ __forceinline__ void final_phase(const bf16_t* __restrict__ hb, const float* __restrict__ part, const float* __restrict__ fg, float* __restrict__ out, int gw, int NGW, int lane) {
    f32x4 g[4];
#pragma unroll
    for (int j = 0; j < 2; ++j) { g[2 * j] = *(const f32x4*)(fg + 8 * lane + 512 * j); g[2 * j + 1] = *(const f32x4*)(fg + 8 * lane + 512 * j + 4); }
    for (int orow = gw; orow < MF; orow += NGW) {
        const size_t row = (size_t)orow;
        float s = part[row * 16 + (lane & 15)];
        s += __shfl_xor(s, 1); s += __shfl_xor(s, 2); s += __shfl_xor(s, 4); s += __shfl_xor(s, 8);
        const float rs = rsqrtf(s * (1.0f / DM) + EPS);
#pragma unroll
        for (int j = 0; j < 2; ++j) {
            const u32x4 hv = __builtin_nontemporal_load((const u32x4*)(hb + row * DM + 8 * lane + 512 * j));
            f32x4 o0, o1;
            o0[0] = bf_lo(hv.x) * rs * g[2 * j][0]; o0[1] = bf_hi(hv.x) * rs * g[2 * j][1]; o0[2] = bf_lo(hv.y) * rs * g[2 * j][2]; o0[3] = bf_hi(hv.y) * rs * g[2 * j][3];
            o1[0] = bf_lo(hv.z) * rs * g[2 * j + 1][0]; o1[1] = bf_hi(hv.z) * rs * g[2 * j + 1][1]; o1[2] = bf_lo(hv.w) * rs * g[2 * j + 1][2]; o1[3] = bf_hi(hv.w) * rs * g[2 * j + 1][3];
            __builtin_nontemporal_store(o0, (f32x4*)(out + (size_t)orow * DM + 8 * lane + 512 * j)); __builtin_nontemporal_store(o1, (f32x4*)(out + (size_t)orow * DM + 8 * lane + 512 * j + 4));
        }
    }
}
typedef const __attribute__((address_space(4))) Args* CArgsP;
#define AP() ({ CArgsP p_ = (CArgsP)__builtin_amdgcn_kernarg_segment_ptr(); asm volatile("" : "+s"(p_)); p_; })
#define WSB(off) ((bf16_t*)(ws + (off)))
#define GRID_BAR() do { XcdBarrier bb_; bb_.bar = (unsigned*)(AP()->ws + WS_CTL); bb_.x = xb_xcc_id(); bb_.st = (volatile LAS unsigned*)(lds + 131072 + 128); xcd_barrier(bb_); } while (0)
__global__ void __launch_bounds__(512, 2) yoco_fwd(Args a_unused) {
    extern __shared__ __attribute__((aligned(16))) unsigned char lds_raw[];
    LAS unsigned char* lds = (LAS unsigned char*)lds_raw;
    cg::grid_group grid = cg::this_grid();
    const int G = gridDim.x, bx = blockIdx.x;
    const int vcu = (G % 8 == 0) ? (bx % 8) * (G / 8) + bx / 8 : bx;
    {
        CArgsP ap = AP(); unsigned char* ws = ap->ws;
        int tid = threadIdx.x; asm volatile("" : "+v"(tid));
        const int lane = tid & 63, wave = __builtin_amdgcn_readfirstlane(tid >> 6);
        if (bx == 0) { for (int i = tid; i < 4096; i += 512) ((unsigned*)(ws + WS_CTL))[i] = 0u; }
        Args acopy; { const __attribute__((address_space(4))) unsigned long long* s_ = (const __attribute__((address_space(4))) unsigned long long*)ap; unsigned long long* d_ = (unsigned long long*)&acopy;
#pragma unroll
          for (int i = 0; i < (int)(sizeof(Args) / 8); ++i) d_[i] = s_[i]; }
        prologue(acopy, lds, vcu * 8 + wave, G * 8, wave, lane);
        __syncthreads();
        if (tid < 2) ((volatile LAS unsigned*)(lds + 131072 + 128))[tid] = 0u;
    }
    grid.sync();
    if (threadIdx.x == 0) { const unsigned r_ = xb_add((unsigned*)(AP()->ws + WS_CTL) + XB_XCNT(xb_xcc_id()), 1u); ((volatile LAS unsigned*)(lds + 131072 + 128))[2] = r_; }
    __syncthreads();
#define REAL_CU(out_c, out_v) do { unsigned* bar_ = (unsigned*)(AP()->ws + WS_CTL); bool ok_ = (G % 8 == 0); \
        for (int j_ = 0; j_ < 8; ++j_) ok_ = ok_ && (xb_ld(&bar_[XB_XCNT(j_)]) == (unsigned)(G / 8)); \
        const int x_ = (int)xb_xcc_id(), r_ = (int)((volatile LAS unsigned*)(lds + 131072 + 128))[2]; \
        ok_ = ok_ && x_ < 8 && r_ < G / 8; \
        out_c = ok_ ? r_ * 8 + x_ : bx;                   \
        out_v = ok_ ? x_ * (G / 8) + r_ : vcu;            \
        out_c = __builtin_amdgcn_readfirstlane(out_c); out_v = __builtin_amdgcn_readfirstlane(out_v); } while (0)
#pragma unroll 1
    for (int layer = 0; layer < 4; ++layer) {
        if (layer < 2) {
            { CArgsP ap = AP(); unsigned char* ws = ap->ws; bf16_t* hb = WSB(WS_HB); float* part = (float*)(ws + WS_SS);
              const bf16_t* Wl = WSB(WS_WAIN) + (size_t)layer * 4096 * DM;
              int t2 = threadIdx.x; asm volatile("" : "+v"(t2));
              if (vcu < 64) meta_ain_job(vcu, hb, Wl, part, WSB(WS_BUF0), WSB(WS_BUF1), __builtin_amdgcn_readfirstlane(t2 >> 6), t2 & 63, lds);
              pg8::Gemm g{hb, Wl, MF, 4096, DM}; pg8::StaticOrder S; S.init(MF, 4096, G, bx);
              EpiAIn E{part, WSB(WS_BUF0), WSB(WS_BUF1), WSB(WS_BUF2), ap->a_conv_w + (size_t)layer * 3 * DM, ap->a_conv_b + (size_t)layer * DM};
              pg8::gemm_phase<EpiAIn, pg8::StaticOrder, true, true>(lds, g, S, E); }
            GRID_BAR();
            { CArgsP ap = AP(); unsigned char* ws = ap->ws; int t2 = threadIdx.x; asm volatile("" : "+v"(t2));
              conv_phase(WSB(WS_BUF0), WSB(WS_BUF1), WSB(WS_BUF2), ap->a_conv_w + (size_t)layer * 3 * DM, ap->a_conv_b + (size_t)layer * DM, bx, G, t2); }
            GRID_BAR();
        } else {
            const int lb = layer - 2;
            if (lb == 0) {
              CArgsP ap = AP(); unsigned char* ws = ap->ws; bf16_t* hb = WSB(WS_HB); float* part = (float*)(ws + WS_SS);
              int t2 = threadIdx.x; asm volatile("" : "+v"(t2)); const int wv = __builtin_amdgcn_readfirstlane(t2 >> 6);
              if (bx == G - 1) { for (int i = t2; i < PADR * DM / 8; i += 512) *(u32x4*)(WSB(WS_BUF0) + (size_t)KM * DM + (size_t)i * 8) = (u32x4){0u, 0u, 0u, 0u}; }
              if (bx == G - 2) { for (int i = t2; i < 1024 * 6; i += 512) *(u32x4*)(WSB(WS_BUF3) + (size_t)(i / 6) * VP + MF + (i % 6) * 8) = (u32x4){0u, 0u, 0u, 0u}; }
              if (vcu < 16) meta_k_job(vcu, hb, WSB(WS_WKQZ), part, WSB(WS_BUF0), wv, t2 & 63, lds);
              else if (vcu < 32) meta_v_job(vcu - 16, hb, WSB(WS_WVT), part, WSB(WS_BUF3), wv, t2 & 63, lds); }
            { CArgsP ap = AP(); unsigned char* ws = ap->ws;
              pg8::Gemm g{WSB(WS_HB), lb ? WSB(WS_WQZ1) : WSB(WS_WKQZ), MF, lb ? 2048 : 3072, DM}; pg8::StaticOrder S; S.init(MF, lb ? 2048 : 3072, G, bx);
              EpiKQZ E{(const float*)(ws + WS_SS), WSB(WS_BUF0), lb ? 1 : 0};
              pg8::gemm_phase<EpiKQZ, pg8::StaticOrder, true, true>(lds, g, S, E); }
            if (lb == 0) {
              CArgsP ap = AP(); unsigned char* ws = ap->ws;
              pg8::Gemm g{WSB(WS_WVT), WSB(WS_HB), DM, MF, DM}; pg8::StaticOrder S; S.init(DM, MF, G, bx);
              EpiVt E{(const float*)(ws + WS_SS), WSB(WS_BUF3)};
              pg8::gemm_phase<EpiVt, pg8::StaticOrder, true, true>(lds, g, S, E); }
            GRID_BAR();
            { CArgsP ap = AP(); unsigned char* ws = ap->ws;
              float lam, oml;
              { int l2 = threadIdx.x; asm volatile("" : "+v"(l2)); l2 &= 63; const float p1 = ap->lq1[lb * 64 + l2] * ap->lk1[lb * 64 + l2], p2 = ap->lq2[lb * 64 + l2] * ap->lk2[lb * 64 + l2];
                const float li = 0.8f - 0.6f * expf(-0.3f * (float)layer);
                lam = expf(wave_sum(p1)) - expf(wave_sum(p2)) + li; oml = 1.0f - li;
                lam = __uint_as_float(__builtin_amdgcn_readfirstlane(__float_as_uint(lam))); oml = __uint_as_float(__builtin_amdgcn_readfirstlane(__float_as_uint(oml))); }
              int rc_, rv_; REAL_CU(rc_, rv_);
              attn_phase(lds, WSB(WS_BUF1), WSB(WS_BUF0), WSB(WS_BUF3), WSB(WS_BUF2), WSB(WS_BUF1), ap->subln_g + lb * 128, lam, oml, rv_, G); }
            GRID_BAR();
        }
        { CArgsP ap = AP(); unsigned char* ws = ap->ws; bf16_t* hb = WSB(WS_HB); float* part = (float*)(ws + WS_SS);
          const bf16_t* Aout = (layer < 2) ? WSB(WS_BUF2) : WSB(WS_BUF1);
          const bf16_t* Wout = (layer < 2) ? WSB(WS_WAOUT) + (size_t)layer * DM * DM : WSB(WS_WBOUT) + (size_t)(layer - 2) * DM * DM;
          int t2 = threadIdx.x; asm volatile("" : "+v"(t2));
          if (layer < 2 && vcu < 16) meta_res_job(vcu, Aout, Wout, hb, part, __builtin_amdgcn_readfirstlane(t2 >> 6), t2 & 63, lds);
          pg8::Gemm g{Aout, Wout, MF, DM, DM}; pg8::StaticOrder S; S.init(MF, DM, G, bx);
          EpiRes E{hb, part};
          pg8::gemm_phase<EpiRes, pg8::StaticOrder, true, true>(lds, g, S, E); }
        GRID_BAR();
    }
    { CArgsP ap = AP(); unsigned char* ws = ap->ws; int t2 = threadIdx.x; asm volatile("" : "+v"(t2));
      final_phase(WSB(WS_HB), (const float*)(ws + WS_SS), ap->final_g, ap->out, vcu * 8 + __builtin_amdgcn_readfirstlane(t2 >> 6), G * 8, t2 & 63); }
}

extern "C" void kernel_launch(void* const* d_in, const int* in_sizes, int n_in, void* d_out, int out_size, void* d_ws, size_t ws_size, hipStream_t stream) {
    static int grid = 0;
    if (grid == 0) {
        int dev = 0, cus = 0, per = 0;
        if (n_in != 18 || out_size != MF * DM || ws_size < WS_END) { fprintf(stderr, "kernel_launch: unexpected shapes (n_in %d out %d ws %zu)\n", n_in, out_size, ws_size); grid = -1; return; }
        (void)hipGetDevice(&dev); (void)hipDeviceGetAttribute(&cus, hipDeviceAttributeMultiprocessorCount, dev);
        (void)hipFuncSetAttribute((const void*)yoco_fwd, hipFuncAttributeMaxDynamicSharedMemorySize, LDS_BYTES);
        (void)hipOccupancyMaxActiveBlocksPerMultiprocessor(&per, (const void*)yoco_fwd, 512, LDS_BYTES);
        if (per < 1) per = 1;
        grid = cus * per;
        fprintf(stderr, "kernel_launch: grid %d (cus %d x %d)\n", grid, cus, per);
    }
    if (grid < 0) return;
    Args a{};
    const float** ap = (const float**)&a;
    for (int i = 0; i < 18; ++i) ap[i] = (const float*)d_in[i];
    a.out = (float*)d_out; a.ws = (unsigned char*)d_ws;
    void* args[] = {&a};
    hipError_t e = hipLaunchCooperativeKernel((const void*)yoco_fwd, dim3(grid), dim3(512), args, LDS_BYTES, stream);
    if (e != hipSuccess) fprintf(stderr, "cooperative launch failed: %s (grid %d)\n", hipGetErrorString(e), grid);
}
```

```cpp
#include <hip/hip_runtime.h>
#include <hip/hip_cooperative_groups.h>
#include <cstdio>
#include <cstdint>
namespace cg = cooperative_groups;
#define ATT_VCU vcu
namespace pg8 {
#define PG8_LAS __attribute__((address_space(3)))
typedef unsigned short bf16_t;
typedef short bf16x8 __attribute__((ext_vector_type(8)));
typedef float f32x4 __attribute__((ext_vector_type(4)));
typedef unsigned u32x4 __attribute__((ext_vector_type(4)));
constexpr int BM = 256, BK = 64, HALF = 128, HTB = HALF * BK * 2  , STAGE_BYTES = 8 * HTB, NXCD = 8, WGM = 4;

__host__ __device__ __forceinline__ int lds_byte(int r, int c) { const int st = (r >> 4) * 2 + (c >> 5), rr = r & 15, cc = c & 31, ob = rr * 64 + cc * 2; return st * 1024 + (ob ^ (((ob >> 9) & 1) << 5)); }
__host__ __device__ __forceinline__ void stage_rc(int b, int& R, int& C) { const int st = b / 1024, sb = b % 1024, swz = sb ^ (((sb >> 9) & 1) << 5); R = (st >> 1) * 16 + swz / 64; C = (st & 1) * 32 + (swz % 64) / 2; }
__host__ __device__ __forceinline__ int perm32(int rho) { const int n = rho >> 4, i = rho & 15; return 8 * (i >> 2) + 4 * n + (i & 3); }

struct Unit { int pm, pn; };
struct Gemm { const bf16_t* A; const bf16_t* Bt; int M, N, K; };

struct StaticOrder {
    int nM, nN, nwg, G, c;
    __host__ __device__ void init(int M, int N, int G_, int c_) { nM = M / BM; nN = N / BM; nwg = nM * nN; G = G_; c = c_; }
    __host__ __device__ bool next(int i, Unit& u) const {
        const long L = (long)i * G + c; if (L >= nwg) return false;
        int wgid = (int)L; { const int q = nwg / NXCD, r = nwg % NXCD, xcd = wgid % NXCD, off = wgid / NXCD; wgid = (xcd < r ? xcd * (q + 1) : r * (q + 1) + (xcd - r) * q) + off; }
        const int nig = WGM * nN, gid = wgid / nig, fm = gid * WGM, gsz = (nM - fm) < WGM ? (nM - fm) : WGM;
        u.pm = fm + ((wgid % nig) % gsz); u.pn = (wgid % nig) / gsz; return true;
    }
    __device__ __forceinline__ void a_ready(const Unit&) const {}
    __device__ __forceinline__ void done(const Unit&) const {}
};

__device__ __forceinline__ unsigned cvt_pk_bf16(float lo, float hi) { unsigned r; asm volatile("v_cvt_pk_bf16_f32 %0, %1, %2" : "=v"(r) : "v"(lo), "v"(hi)); return r; }
typedef float f32x2 __attribute__((ext_vector_type(2)));
template <class Epi, class Sched, bool ALIGN_EPI = false, bool SP2 = false>
__device__ __forceinline__ void gemm_phase(PG8_LAS unsigned char* lds, const Gemm g, const Sched& S, const Epi& E) {
    int tid = threadIdx.x; asm volatile("" : "+v"(tid)); const int wid = __builtin_amdgcn_readfirstlane(tid >> 6), lane = tid & 63, wr = wid >> 2, wc = wid & 3, fr = lane & 15, fq = lane >> 4;
    const int K = g.K, nt = K / BK;
    unsigned voffA[2], voffB[2];
#pragma unroll
    for (int i = 0; i < 2; ++i) { int R, C; stage_rc(tid * 16 + i * 8192, R, C); const int Rb = Epi::PERM ? ((R & ~31) + perm32(R & 31)) : R;
        voffA[i] = (unsigned)(R * K + C) * 2u; voffB[i] = (unsigned)(Rb * K + C) * 2u; }
    const size_t kstep = (size_t)(BK * 2);
    const size_t hstep = (size_t)HALF * K * 2;
    const size_t tstep = 2 * hstep;
    const unsigned ldsw = (unsigned)wid * 1024u;
    const int aoff = lds_byte(wr * 64 + fr, fq * 8), boff = lds_byte(wc * 32 + fr, fq * 8);
#define PG8_SA(b, h) (((b) * 2 + (h)) * HTB)
#define PG8_SB(b, h) ((4 + (b) * 2 + (h)) * HTB)
#define PG8_STAGE(bufoff, gbase, voff) do { _Pragma("unroll") for (int _i = 0; _i < 2; ++_i) \
        __builtin_amdgcn_global_load_lds((const unsigned*)((const char*)(gbase) + (voff)[_i]), (PG8_LAS unsigned*)(lds + (bufoff) + ldsw + _i * 8192), 16, 0, 0); } while (0)
#define PG8_LDA(dst, b, h) do { _Pragma("unroll") for (int m = 0; m < 4; ++m) _Pragma("unroll") for (int k = 0; k < 2; ++k) dst[m][k] = *(const PG8_LAS bf16x8*)(lds + PG8_SA(b, h) + aoff + m * 2048 + k * 1024); } while (0)
#define PG8_LDB(dst, b, h) do { _Pragma("unroll") for (int n = 0; n < 2; ++n) _Pragma("unroll") for (int k = 0; k < 2; ++k) dst[n][k] = *(const PG8_LAS bf16x8*)(lds + PG8_SB(b, h) + boff + n * 2048 + k * 1024); } while (0)
#define PG8_MMA(ai, bj, At, Bt) do { __builtin_amdgcn_s_setprio(1); _Pragma("unroll") for (int m = 0; m < 4; ++m) _Pragma("unroll") for (int n = 0; n < 2; ++n) _Pragma("unroll") for (int k = 0; k < 2; ++k) \
        acc[ai][bj][m][n] = __builtin_amdgcn_mfma_f32_16x16x32_bf16(Bt[n][k], At[m][k], acc[ai][bj][m][n], 0, 0, 0); __builtin_amdgcn_s_setprio(0); } while (0)
#define PG8_WAIT_V(n) asm volatile("s_waitcnt vmcnt(" #n ")" ::: "memory")
#define PG8_WAIT_L(n) asm volatile("s_waitcnt lgkmcnt(" #n ")" ::: "memory")
#define PG8_BAR __builtin_amdgcn_s_barrier()
#define PG8_SCHED __builtin_amdgcn_sched_barrier(0)
    Unit cur, nxt; int ui = 0;
    if (!S.next(0, cur)) return;
    f32x4 acc[2][2][4][2];
#pragma unroll
    for (int a = 0; a < 2; ++a)
#pragma unroll
        for (int b = 0; b < 2; ++b)
#pragma unroll
            for (int m = 0; m < 4; ++m)
#pragma unroll
                for (int n = 0; n < 2; ++n) acc[a][b][m][n] = (f32x4){0.f, 0.f, 0.f, 0.f};
    bf16x8 At[4][2], B0[2][2], B1[2][2];
    const char* cA = (const char*)g.A + (size_t)cur.pm * tstep; const char* cB = (const char*)g.Bt + (size_t)cur.pn * tstep;
    S.a_ready(cur);
    if constexpr (SP2) {
        PG8_STAGE(PG8_SB(0, 0), cB, voffB); PG8_STAGE(PG8_SB(0, 1), cB + hstep, voffB); PG8_STAGE(PG8_SA(0, 0), cA, voffA); PG8_STAGE(PG8_SA(0, 1), cA + hstep, voffA);
        if (wr == 1) PG8_BAR;
        PG8_WAIT_V(2); PG8_BAR;
        PG8_STAGE(PG8_SB(1, 0), cB + kstep, voffB); PG8_STAGE(PG8_SA(1, 0), cA + kstep, voffA); PG8_STAGE(PG8_SB(1, 1), cB + hstep + kstep, voffB);
        PG8_WAIT_V(6); PG8_BAR;
    } else {
        PG8_STAGE(PG8_SB(0, 0), cB, voffB); PG8_STAGE(PG8_SA(0, 0), cA, voffA); PG8_STAGE(PG8_SB(0, 1), cB + hstep, voffB); PG8_STAGE(PG8_SA(0, 1), cA + hstep, voffA);
        if (wr == 1) PG8_BAR;
        PG8_WAIT_V(4); PG8_BAR;
        PG8_STAGE(PG8_SB(1, 0), cB + kstep, voffB); PG8_STAGE(PG8_SA(1, 0), cA + kstep, voffA); PG8_STAGE(PG8_SB(1, 1), cB + hstep + kstep, voffB);
        PG8_WAIT_V(6); PG8_BAR;
    }
    for (;;) {
        const bool has_next = S.next(ui + 1, nxt);
        const char* nA = has_next ? (const char*)g.A + (size_t)nxt.pm * tstep : cA; const char* nB = has_next ? (const char*)g.Bt + (size_t)nxt.pn * tstep : cB;
        for (int t = 0; t < nt; t += 2) {
            const bool last = (t == nt - 2);
            const char* a1 = cA + (size_t)(t + 1) * kstep;
            const char* a2 = last ? nA : cA + (size_t)(t + 2) * kstep; const char* b2 = last ? nB : cB + (size_t)(t + 2) * kstep;
            const char* a3 = a2 + kstep; const char* b3 = b2 + kstep;
            if (last && has_next) S.a_ready(nxt);
            if constexpr (SP2) {
            PG8_LDB(B0, 0, 0); PG8_LDB(B1, 0, 1); PG8_SCHED; PG8_LDA(At, 0, 0); PG8_STAGE(PG8_SA(1, 1), a1 + hstep, voffA);
            PG8_WAIT_V(8); PG8_WAIT_L(0); PG8_BAR; PG8_MMA(0, 0, At, B0); PG8_MMA(0, 1, At, B1); PG8_BAR; PG8_SCHED;
            PG8_LDA(At, 0, 1); PG8_STAGE(PG8_SB(0, 0), b2, voffB); PG8_STAGE(PG8_SB(0, 1), b2 + hstep, voffB); PG8_STAGE(PG8_SA(0, 0), a2, voffA);
            PG8_WAIT_V(8); PG8_WAIT_L(0); PG8_BAR; PG8_MMA(1, 0, At, B0); PG8_MMA(1, 1, At, B1); PG8_BAR; PG8_SCHED;
            PG8_LDB(B0, 1, 0); PG8_LDB(B1, 1, 1); PG8_SCHED; PG8_LDA(At, 1, 0); PG8_STAGE(PG8_SA(0, 1), a2 + hstep, voffA);
            PG8_WAIT_V(8); PG8_WAIT_L(0); PG8_BAR; PG8_MMA(0, 0, At, B0); PG8_MMA(0, 1, At, B1); PG8_BAR; PG8_SCHED;
            PG8_LDA(At, 1, 1); PG8_STAGE(PG8_SB(1, 0), b3, voffB); PG8_STAGE(PG8_SB(1, 1), b3 + hstep, voffB); PG8_STAGE(PG8_SA(1, 0), a3, voffA);
            PG8_WAIT_V(8); PG8_WAIT_L(0); PG8_BAR; PG8_MMA(1, 0, At, B0); PG8_MMA(1, 1, At, B1); PG8_BAR; PG8_SCHED;
            } else {
            PG8_LDB(B0, 0, 0); PG8_SCHED; PG8_LDA(At, 0, 0); PG8_STAGE(PG8_SA(1, 1), a1 + hstep, voffA);
            PG8_WAIT_L(8); PG8_BAR; PG8_WAIT_L(0); PG8_MMA(0, 0, At, B0); PG8_BAR; PG8_SCHED;
            PG8_LDB(B1, 0, 1); PG8_STAGE(PG8_SB(0, 0), b2, voffB);
            PG8_BAR; PG8_WAIT_L(0); PG8_MMA(0, 1, At, B1); PG8_BAR;
            PG8_LDA(At, 0, 1); PG8_STAGE(PG8_SA(0, 0), a2, voffA);
            PG8_BAR; PG8_WAIT_L(0); PG8_MMA(1, 0, At, B0); PG8_BAR; PG8_SCHED;
            PG8_STAGE(PG8_SB(0, 1), b2 + hstep, voffB);
            PG8_WAIT_V(6); PG8_BAR; PG8_MMA(1, 1, At, B1); PG8_BAR;
            PG8_LDB(B0, 1, 0); PG8_SCHED; PG8_LDA(At, 1, 0); PG8_STAGE(PG8_SA(0, 1), a2 + hstep, voffA);
            PG8_WAIT_L(8); PG8_BAR; PG8_WAIT_L(0); PG8_MMA(0, 0, At, B0); PG8_BAR; PG8_SCHED;
            PG8_LDB(B1, 1, 1); PG8_STAGE(PG8_SB(1, 0), b3, voffB);
            PG8_BAR; PG8_WAIT_L(0); PG8_MMA(0, 1, At, B1); PG8_BAR;
            PG8_LDA(At, 1, 1); PG8_STAGE(PG8_SA(1, 0), a3, voffA);
            PG8_BAR; PG8_WAIT_L(0); PG8_MMA(1, 0, At, B0); PG8_BAR; PG8_SCHED;
            PG8_STAGE(PG8_SB(1, 1), b3 + hstep, voffB);
            PG8_WAIT_V(6); PG8_BAR; PG8_MMA(1, 1, At, B1); PG8_BAR;
            }
        }
        if constexpr (ALIGN_EPI) { if (wr == 0) PG8_BAR; }
        if constexpr (!Epi::AFTER_DRAIN) { E(acc, cur, wr, wc, fr, fq); S.done(cur); }
        if (!has_next) break;
#pragma unroll
        for (int a = 0; a < 2; ++a)
#pragma unroll
            for (int b = 0; b < 2; ++b)
#pragma unroll
                for (int m = 0; m < 4; ++m)
#pragma unroll
                    for (int n = 0; n < 2; ++n) acc[a][b][m][n] = (f32x4){0.f, 0.f, 0.f, 0.f};
        cur = nxt; cA = nA; cB = nB; ++ui;
        if constexpr (ALIGN_EPI) { if (wr == 1) PG8_BAR; }
    }
    PG8_WAIT_V(0);
    if constexpr (!ALIGN_EPI) { if (wr == 0) PG8_BAR; }
    PG8_BAR;
    if constexpr (Epi::AFTER_DRAIN) { E.fused(acc, cur, wr, wc, fr, fq, lds, wid, lane); S.done(cur); }
#undef PG8_SA
#undef PG8_SB
#undef PG8_STAGE
#undef PG8_LDA
#undef PG8_LDB
#undef PG8_MMA
#undef PG8_WAIT_V
#undef PG8_WAIT_L
#undef PG8_BAR
#undef PG8_SCHED
}
}
#define LAS __attribute__((address_space(3)))
typedef unsigned short bf16_t;
typedef short bf16x8 __attribute__((ext_vector_type(8)));
typedef float f32x4 __attribute__((ext_vector_type(4)));
typedef float f32x16 __attribute__((ext_vector_type(16)));
typedef unsigned u32x4 __attribute__((ext_vector_type(4)));
typedef unsigned u32x2 __attribute__((ext_vector_type(2)));
constexpr int DM = 1024, NBATCH = 16, SEQ = 2048, MF = NBATCH * SEQ;
constexpr int HM = MF;
constexpr int KM = MF;
constexpr int VP = MF + 64;
constexpr size_t BUF_ELEMS = (size_t)33792 * 1024;
constexpr int PADR = 48, NMETA = 16;
constexpr float EPS = 1e-6f;
constexpr float QSCALE = 0.125f * 1.4426950408889634f;
constexpr size_t MiB = 1u << 20;
constexpr size_t WS_WAIN = 0, WS_WAOUT = 16 * MiB, WS_WKQZ = 20 * MiB, WS_WVT = 26 * MiB, WS_WQZ1 = 28 * MiB, WS_WBOUT = 32 * MiB, WS_SS = 36 * MiB, WS_CTL = 39 * MiB,
                 WS_HB = 40 * MiB, WS_BUF0 = 106 * MiB, WS_BUF1 = 172 * MiB, WS_BUF2 = 238 * MiB, WS_BUF3 = 304 * MiB, WS_BUF4 = 370 * MiB, WS_END = 436 * MiB;
constexpr int LDS_BYTES = 135168;

using pg8::cvt_pk_bf16;
__device__ __forceinline__ float bf_lo(unsigned w) { return __uint_as_float(w << 16); }
__device__ __forceinline__ float bf_hi(unsigned w) { return __uint_as_float(w & 0xffff0000u); }
__device__ __forceinline__ float fast_exp2(float x) { return __builtin_amdgcn_exp2f(x); }
__device__ __forceinline__ float silu_f(float z) { return z * __builtin_amdgcn_rcpf(1.0f + fast_exp2(-1.4426950408889634f * z)); }
__device__ __forceinline__ float wave_sum(float v) {
#pragma unroll
    for (int o = 1; o < 64; o <<= 1) v += __shfl_xor(v, o);
    return v;
}
__device__ __forceinline__ float row_rstd(const float* part, int row, int fq) {
    const f32x4 p = *(const f32x4*)(part + (size_t)row * 16 + 4 * fq);
    float s = (p[0] + p[1]) + (p[2] + p[3]);
    s += __shfl_xor(s, 16); s += __shfl_xor(s, 32);
    return rsqrtf(s * (1.0f / DM) + EPS);
}

__device__ __forceinline__ f32x4 rstd_load(const float* part, int row, int fq) { return *(const f32x4*)(part + (size_t)row * 16 + 4 * fq); }
__device__ __forceinline__ float rstd_reduce(const f32x4 p) {
    float s = (p[0] + p[1]) + (p[2] + p[3]);
    s += __shfl_xor(s, 16); s += __shfl_xor(s, 32);
    return rsqrtf(s * (1.0f / DM) + EPS);
}
__device__ __forceinline__ float dpp_ror1(float x) { return __int_as_float(__builtin_amdgcn_update_dpp(0, __float_as_int(x), 0x121, 0xF, 0xF, false)); }
__device__ __forceinline__ float dpp_ror2(float x) { return __int_as_float(__builtin_amdgcn_update_dpp(0, __float_as_int(x), 0x122, 0xF, 0xF, false)); }
__device__ __forceinline__ float dpp_shr1(float old, float x) { return __int_as_float(__builtin_amdgcn_update_dpp(__float_as_int(old), __float_as_int(x), 0x111, 0xF, 0xF, false)); }
__device__ __forceinline__ float dpp_shr2(float old, float x) { return __int_as_float(__builtin_amdgcn_update_dpp(__float_as_int(old), __float_as_int(x), 0x112, 0xF, 0xF, false)); }
struct EpiAIn {
    static constexpr bool PERM = false, AFTER_DRAIN = false;
    const float* part; bf16_t* vbuf; bf16_t* gzbuf; bf16_t* ybuf; const float* cw; const float* cb;
    __device__ __forceinline__ void operator()(const f32x4 (&acc)[2][2][4][2], const pg8::Unit& u, int wr, int wc, int fr, int fq) const {
        const int ch0 = 64 * u.pn + 16 * wc + 4 * fq;
        const f32x4 w0 = *(const f32x4*)(cw + ch0), w1 = *(const f32x4*)(cw + DM + ch0), w2 = *(const f32x4*)(cw + 2 * DM + ch0), bb = *(const f32x4*)(cb + ch0);
        f32x4 pp[2][4];
#pragma unroll
        for (int ai = 0; ai < 2; ++ai)
#pragma unroll
            for (int m = 0; m < 4; ++m) pp[ai][m] = rstd_load(part, u.pm * 256 + ai * 128 + wr * 64 + m * 16 + fr, fq);
#pragma unroll
        for (int ai = 0; ai < 2; ++ai) {
            f32x4 vprev = (f32x4){0.f, 0.f, 0.f, 0.f};
#pragma unroll
            for (int m = 0; m < 4; ++m) {
                const int row = u.pm * 256 + ai * 128 + wr * 64 + m * 16 + fr;
                const float rs = rstd_reduce(pp[ai][m]);
                const f32x4 b = acc[ai][0][m][0] * rs, c = acc[ai][0][m][1] * rs, hin = acc[ai][1][m][0] * rs, z = acc[ai][1][m][1] * rs;
                const f32x4 v = c * hin;
                f32x4 gz, y;
#pragma unroll
                for (int j = 0; j < 4; ++j) {
                    gz[j] = b[j] * silu_f(z[j]);
                    const float p1 = dpp_shr1(dpp_ror1(vprev[j]), v[j]), p2 = dpp_shr2(dpp_ror2(vprev[j]), v[j]);
                    y[j] = gz[j] * (w0[j] * p2 + w1[j] * p1 + w2[j] * v[j] + bb[j]);
                }
                const size_t o = (size_t)row * DM + ch0;
                if (m == 0 && fr < 2) {
                    u32x2 wv, wg; wv.x = cvt_pk_bf16(v[0], v[1]); wv.y = cvt_pk_bf16(v[2], v[3]); wg.x = cvt_pk_bf16(gz[0], gz[1]); wg.y = cvt_pk_bf16(gz[2], gz[3]);
                    *(u32x2*)(vbuf + o) = wv; *(u32x2*)(gzbuf + o) = wg;
                } else {
                    u32x2 wy; wy.x = cvt_pk_bf16(y[0], y[1]); wy.y = cvt_pk_bf16(y[2], y[3]);
                    *(u32x2*)(ybuf + o) = wy;
                    if (m == 3 && fr >= 14) { u32x2 wv; wv.x = cvt_pk_bf16(v[0], v[1]); wv.y = cvt_pk_bf16(v[2], v[3]); *(u32x2*)(vbuf + o) = wv; }
                }
                vprev = v;
            }
        }
    }
};
struct EpiRes {
    static constexpr bool PERM = true, AFTER_DRAIN = false;
    bf16_t* hb; float* part;
    __device__ __forceinline__ void operator()(const f32x4 (&acc)[2][2][4][2], const pg8::Unit& u, int wr, int wc, int fr, int fq) const {
        u32x4 old[2][4][2];
#pragma unroll
        for (int ai = 0; ai < 2; ++ai)
#pragma unroll
            for (int m = 0; m < 4; ++m)
#pragma unroll
                for (int bj = 0; bj < 2; ++bj)
                    old[ai][m][bj] = *(const u32x4*)(hb + (size_t)(u.pm * 256 + ai * 128 + wr * 64 + m * 16 + fr) * DM + u.pn * 256 + bj * 128 + wc * 32 + 8 * fq);
#pragma unroll
        for (int ai = 0; ai < 2; ++ai)
#pragma unroll
            for (int m = 0; m < 4; ++m) {
                const int row = u.pm * 256 + ai * 128 + wr * 64 + m * 16 + fr;
                float ssq = 0.f;
#pragma unroll
                for (int bj = 0; bj < 2; ++bj) {
                    bf16_t* p = hb + (size_t)row * DM + u.pn * 256 + bj * 128 + wc * 32 + 8 * fq;
                    const u32x4 o4 = old[ai][m][bj];
                    const f32x4 a0 = acc[ai][bj][m][0], a1 = acc[ai][bj][m][1];
                    float v[8];
                    v[0] = bf_lo(o4.x) + a0[0]; v[1] = bf_hi(o4.x) + a0[1]; v[2] = bf_lo(o4.y) + a0[2]; v[3] = bf_hi(o4.y) + a0[3];
                    v[4] = bf_lo(o4.z) + a1[0]; v[5] = bf_hi(o4.z) + a1[1]; v[6] = bf_lo(o4.w) + a1[2]; v[7] = bf_hi(o4.w) + a1[3];
#pragma unroll
                    for (int i = 0; i < 8; ++i) ssq += v[i] * v[i];
                    u32x4 w; w.x = cvt_pk_bf16(v[0], v[1]); w.y = cvt_pk_bf16(v[2], v[3]); w.z = cvt_pk_bf16(v[4], v[5]); w.w = cvt_pk_bf16(v[6], v[7]);
                    *(u32x4*)p = w;
                }
                ssq += __shfl_xor(ssq, 16); ssq += __shfl_xor(ssq, 32);
                if (fq == 0) part[(size_t)row * 16 + 4 * u.pn + wc] = ssq;
            }
    }
};
struct EpiKQZ {
    static constexpr bool PERM = true, AFTER_DRAIN = false;
    const float* part; bf16_t* kqz; int tbase;
    __device__ __forceinline__ void operator()(const f32x4 (&acc)[2][2][4][2], const pg8::Unit& u, int wr, int wc, int fr, int fq) const {
        const int t = (u.pn >> 2) + tbase;
        bf16_t* dst = kqz + (size_t)t * BUF_ELEMS;
        const float sc = (t == 1) ? QSCALE : 1.0f;
        const int col0 = (u.pn & 3) * 256 + wc * 32 + 8 * fq;
        f32x4 pp[2][4];
#pragma unroll
        for (int ai = 0; ai < 2; ++ai)
#pragma unroll
            for (int m = 0; m < 4; ++m) pp[ai][m] = rstd_load(part, u.pm * 256 + ai * 128 + wr * 64 + m * 16 + fr, fq);
#pragma unroll
        for (int ai = 0; ai < 2; ++ai)
#pragma unroll
            for (int m = 0; m < 4; ++m) {
                const int row = u.pm * 256 + ai * 128 + wr * 64 + m * 16 + fr;
                const float rs = rstd_reduce(pp[ai][m]) * sc;
#pragma unroll
                for (int bj = 0; bj < 2; ++bj) {
                    f32x4 a0 = acc[ai][bj][m][0] * rs, a1 = acc[ai][bj][m][1] * rs;
                    if (t == 2) {
#pragma unroll
                        for (int j = 0; j < 4; ++j) { a0[j] = silu_f(a0[j]); a1[j] = silu_f(a1[j]); }
                    }
                    u32x4 w; w.x = cvt_pk_bf16(a0[0], a0[1]); w.y = cvt_pk_bf16(a0[2], a0[3]); w.z = cvt_pk_bf16(a1[0], a1[1]); w.w = cvt_pk_bf16(a1[2], a1[3]);
                    *(u32x4*)(dst + (size_t)row * DM + col0 + bj * 128) = w;
                }
            }
    }
};
struct EpiVt {
    static constexpr bool PERM = true, AFTER_DRAIN = false;
    const float* part; bf16_t* vt;
    __device__ __forceinline__ void operator()(const f32x4 (&acc)[2][2][4][2], const pg8::Unit& u, int wr, int wc, int fr, int fq) const {
        const int lane = fr + 16 * fq;
        float rsl;
        { const int tok = u.pn * 256 + 128 * (lane >> 5) + 32 * wc + (lane & 31);
          const f32x4* p = (const f32x4*)(part + (size_t)tok * 16);
          const f32x4 p0 = p[0], p1 = p[1], p2 = p[2], p3 = p[3];
          const float s = ((p0[0] + p0[1]) + (p0[2] + p0[3])) + ((p1[0] + p1[1]) + (p1[2] + p1[3])) + ((p2[0] + p2[1]) + (p2[2] + p2[3])) + ((p3[0] + p3[1]) + (p3[2] + p3[3]));
          rsl = rsqrtf(s * (1.0f / DM) + EPS); }
        float rs[2][8];
#pragma unroll
        for (int bj = 0; bj < 2; ++bj)
#pragma unroll
            for (int i = 0; i < 8; ++i) rs[bj][i] = __shfl(rsl, 32 * bj + 8 * fq + i);
#pragma unroll
        for (int ai = 0; ai < 2; ++ai)
#pragma unroll
            for (int m = 0; m < 4; ++m) {
                const int e = u.pm * 256 + ai * 128 + wr * 64 + m * 16 + fr;
#pragma unroll
                for (int bj = 0; bj < 2; ++bj)
#pragma unroll
                    for (int n = 0; n < 2; ++n) {
                        const f32x4 a = acc[ai][bj][m][n];
                        u32x2 w; w.x = cvt_pk_bf16(a[0] * rs[bj][4 * n + 0], a[1] * rs[bj][4 * n + 1]); w.y = cvt_pk_bf16(a[2] * rs[bj][4 * n + 2], a[3] * rs[bj][4 * n + 3]);
                        *(u32x2*)(vt + (size_t)e * VP + u.pn * 256 + bj * 128 + wc * 32 + 16 * (fq >> 1) + 8 * n + 4 * (fq & 1)) = w;
                    }
            }
    }
};

__device__ __forceinline__ void mini_gemm4(const bf16_t* __restrict__ A, const bf16_t* __restrict__ w0, const bf16_t* __restrict__ w1, const bf16_t* __restrict__ w2, const bf16_t* __restrict__ w3, f32x4 (&acc)[4], int wave, int lane, LAS unsigned char* lds) {
    const int off = (lane & 15) * DM + (lane >> 4) * 8 + wave * 128;
    const bf16_t* ap = A + off; const bf16_t* p0 = w0 + off; const bf16_t* p1 = w1 + off; const bf16_t* p2 = w2 + off; const bf16_t* p3 = w3 + off;
    bf16x8 bv[4], a0[4], a1[4], a2[4], a3[4];
#pragma unroll
    for (int kk = 0; kk < 4; ++kk) { bv[kk] = *(const bf16x8*)(ap + kk * 32); a0[kk] = *(const bf16x8*)(p0 + kk * 32); a1[kk] = *(const bf16x8*)(p1 + kk * 32); a2[kk] = *(const bf16x8*)(p2 + kk * 32); a3[kk] = *(const bf16x8*)(p3 + kk * 32); }
#pragma unroll
    for (int i = 0; i < 4; ++i) acc[i] = (f32x4){0.f, 0.f, 0.f, 0.f};
#pragma unroll
    for (int kk = 0; kk < 4; ++kk) {
        acc[0] = __builtin_amdgcn_mfma_f32_16x16x32_bf16(a0[kk], bv[kk], acc[0], 0, 0, 0); acc[1] = __builtin_amdgcn_mfma_f32_16x16x32_bf16(a1[kk], bv[kk], acc[1], 0, 0, 0);
        acc[2] = __builtin_amdgcn_mfma_f32_16x16x32_bf16(a2[kk], bv[kk], acc[2], 0, 0, 0); acc[3] = __builtin_amdgcn_mfma_f32_16x16x32_bf16(a3[kk], bv[kk], acc[3], 0, 0, 0);
    }
    LAS f32x4* red = (LAS f32x4*)lds;
#pragma unroll
    for (int i = 0; i < 4; ++i) red[(wave * 4 + i) * 64 + lane] = acc[i];
    __syncthreads();
    if (wave == 0) {
#pragma unroll
        for (int w = 1; w < 8; ++w)
#pragma unroll
            for (int i = 0; i < 4; ++i) acc[i] += red[(w * 4 + i) * 64 + lane];
    }
    __syncthreads();
}
__device__ __forceinline__ float meta_rstd(const float* part, int m) {
    const f32x4* p = (const f32x4*)(part + (size_t)(HM + m) * 16);
    const f32x4 p0 = p[0], p1 = p[1], p2 = p[2], p3 = p[3];
    const float s = ((p0[0] + p0[1]) + (p0[2] + p0[3])) + ((p1[0] + p1[1]) + (p1[2] + p1[3])) + ((p2[0] + p2[1]) + (p2[2] + p2[3])) + ((p3[0] + p3[1]) + (p3[2] + p3[3]));
    return rsqrtf(s * (1.0f / DM) + EPS);
}
__device__ __forceinline__ void meta_ain_job(int j, const bf16_t* hb, const bf16_t* W, const float* part, bf16_t* vbuf, bf16_t* gzbuf, int wave, int lane, LAS unsigned char* lds) {
    const int pn = j >> 2, wc = j & 3, fr = lane & 15, fq = lane >> 4;
    const bf16_t* wb = W + (size_t)(256 * pn + 32 * wc) * DM;
    f32x4 acc[4];
    mini_gemm4(hb + (size_t)HM * DM, wb, wb + 16 * DM, wb + 128 * DM, wb + 144 * DM, acc, wave, lane, lds);
    if (wave != 0) return;
    const float rs = meta_rstd(part, fr);
    const f32x4 bb = acc[0] * rs, c = acc[1] * rs, hin = acc[2] * rs, z = acc[3] * rs;
    const f32x4 v = c * hin; f32x4 gz;
#pragma unroll
    for (int q = 0; q < 4; ++q) gz[q] = bb[q] * silu_f(z[q]);
    u32x2 wv, wg; wv.x = cvt_pk_bf16(v[0], v[1]); wv.y = cvt_pk_bf16(v[2], v[3]); wg.x = cvt_pk_bf16(gz[0], gz[1]); wg.y = cvt_pk_bf16(gz[2], gz[3]);
    const size_t o = (size_t)(HM + fr) * DM + 64 * pn + 16 * wc + 4 * fq;
    *(u32x2*)(vbuf + o) = wv; *(u32x2*)(gzbuf + o) = wg;
}
__device__ __forceinline__ void meta_res_job(int j, const bf16_t* A, const bf16_t* W, bf16_t* hb, float* part, int wave, int lane, LAS unsigned char* lds) {
    const int fr = lane & 15, fq = lane >> 4;
    const bf16_t* wb = W + (size_t)(64 * j) * DM;
    f32x4 acc[4];
    mini_gemm4(A + (size_t)HM * DM, wb, wb + 16 * DM, wb + 32 * DM, wb + 48 * DM, acc, wave, lane, lds);
    if (wave != 0) return;
    float ssq = 0.f;
#pragma unroll
    for (int i = 0; i < 4; ++i) {
        bf16_t* p = hb + (size_t)(HM + fr) * DM + 64 * j + 16 * i + 4 * fq;
        const u32x2 old = *(const u32x2*)p;
        const float v0 = bf_lo(old.x) + acc[i][0], v1 = bf_hi(old.x) + acc[i][1], v2 = bf_lo(old.y) + acc[i][2], v3 = bf_hi(old.y) + acc[i][3];
        ssq += (v0 * v0 + v1 * v1) + (v2 * v2 + v3 * v3);
        u32x2 w; w.x = cvt_pk_bf16(v0, v1); w.y = cvt_pk_bf16(v2, v3); *(u32x2*)p = w;
    }
    ssq += __shfl_xor(ssq, 16); ssq += __shfl_xor(ssq, 32);
    if (fq == 0) part[(size_t)(HM + fr) * 16 + j] = ssq;
}
__device__ __forceinline__ void meta_k_job(int j, const bf16_t* hb, const bf16_t* W, const float* part, bf16_t* kb, int wave, int lane, LAS unsigned char* lds) {
    const int fr = lane & 15, fq = lane >> 4;
    const bf16_t* wb = W + (size_t)(64 * j) * DM;
    f32x4 acc[4];
    mini_gemm4(hb + (size_t)HM * DM, wb, wb + 16 * DM, wb + 32 * DM, wb + 48 * DM, acc, wave, lane, lds);
    if (wave != 0) return;
    const float rs = meta_rstd(part, fr);
#pragma unroll
    for (int i = 0; i < 4; ++i) { const f32x4 a = acc[i] * rs; u32x2 w; w.x = cvt_pk_bf16(a[0], a[1]); w.y = cvt_pk_bf16(a[2], a[3]);
        *(u32x2*)(kb + (size_t)(KM + PADR + fr) * DM + 64 * j + 16 * i + 4 * fq) = w; }
}
__device__ __forceinline__ void meta_v_job(int j, const bf16_t* hb, const bf16_t* Wv, const float* part, bf16_t* vt, int wave, int lane, LAS unsigned char* lds) {
    const int fr = lane & 15, fq = lane >> 4;
    const bf16_t* wb = Wv + (size_t)(64 * j) * DM;
    f32x4 acc[4];
    mini_gemm4(hb + (size_t)HM * DM, wb, wb + 16 * DM, wb + 32 * DM, wb + 48 * DM, acc, wave, lane, lds);
    if (wave != 0) return;
    const float rs = meta_rstd(part, fr);
    const int pos = 8 * ((fr >> 2) & 1) + 4 * (fr >> 3) + (fr & 3);
#pragma unroll
    for (int i = 0; i < 4; ++i)
#pragma unroll
        for (int r = 0; r < 4; ++r) { const int e = 64 * j + 16 * i + 4 * fq + r; vt[(size_t)e * VP + MF + PADR + pos] = (bf16_t)(cvt_pk_bf16(acc[i][r] * rs, 0.f) & 0xffffu); }
}
#define XB_TMO      128
#define XB_XCNT(j)  (256  + 64 * (j))
#define XB_XSUB(j)  (1280 + 64 * (j))
#define XB_XGEN(j)  (2304 + 64 * (j))
#define XB_TOP      3328
#define XB_TOPGEN   3392
#define XCD_BAR_WORDS 3456
#define XB_SPIN_CAP (1u << 18)

__device__ __forceinline__ unsigned xb_ld(unsigned* p)              { return __hip_atomic_load(p, __ATOMIC_RELAXED, __HIP_MEMORY_SCOPE_AGENT); }
__device__ __forceinline__ unsigned xb_add(unsigned* p, unsigned v) { return __hip_atomic_fetch_add(p, v, __ATOMIC_RELAXED, __HIP_MEMORY_SCOPE_AGENT); }
__device__ __forceinline__ unsigned xb_xcc_id() { return (unsigned)__builtin_amdgcn_s_getreg((3 << 11) | 20) & 0xFu; }
#define XB_SPIN(cond, bar) do { unsigned _sp = 0; while (cond) { __builtin_amdgcn_s_sleep(1); \
    if ((++_sp & 255u) == 0u) { if (xb_ld(&(bar)[XB_TMO])) break; if (_sp > XB_SPIN_CAP) { atomicAdd(&(bar)[XB_TMO], 1u); break; } } } } while (0)

struct XcdBarrier {
    unsigned* bar; unsigned x;
    volatile LAS unsigned* st;
};

__device__ __forceinline__ XcdBarrier xcd_barrier_post(unsigned* bar, volatile LAS unsigned* st) {
    XcdBarrier b; b.bar = bar; b.x = xb_xcc_id(); b.st = st;
    if (threadIdx.x == 0) (void)xb_add(&bar[XB_XCNT(b.x)], 1u);
    return b;
}
__device__ __forceinline__ void xcd_barrier_complete(unsigned* bar, unsigned x, unsigned& nloc, unsigned& nx) {
    const unsigned G = gridDim.x * gridDim.y * gridDim.z;
    unsigned sum, cnt, mine, sp = 0u;
    for (;;) {
        sum = 0u; cnt = 0u; mine = 0u;
#pragma unroll
        for (unsigned j = 0; j < 16; ++j) { const unsigned c = xb_ld(&bar[XB_XCNT(j)]); sum += c; cnt += (c > 0u) ? 1u : 0u; mine = (j == x) ? c : mine; }
        if (sum == G) break;
        __builtin_amdgcn_s_sleep(1);
        if ((++sp & 255u) == 0u) { if (xb_ld(&bar[XB_TMO])) break; if (sp > XB_SPIN_CAP) { atomicAdd(&bar[XB_TMO], 1u); break; } }
    }
    nloc = mine > 0u ? mine : 1u; nx = cnt > 0u ? cnt : 1u;
}

__device__ __forceinline__ void xcd_barrier(const XcdBarrier& b) {
    asm volatile("s_waitcnt vmcnt(0)" ::: "memory");
    __syncthreads();
    if (threadIdx.x == 0) {
        unsigned* bar = b.bar;
        __builtin_amdgcn_s_waitcnt(0);
        unsigned nloc = b.st[0], nx = b.st[1];
        if (nloc == 0u) { xcd_barrier_complete(bar, b.x, nloc, nx); b.st[0] = nloc; b.st[1] = nx; }
        const unsigned old = xb_add(&bar[XB_XSUB(b.x)], 1u);
        const unsigned gen = old / nloc;
        if (old + 1u == (gen + 1u) * nloc) {
            __builtin_amdgcn_fence(__ATOMIC_RELEASE, "agent");
            asm volatile("s_waitcnt vmcnt(0)" ::: "memory");
            const unsigned og = xb_add(&bar[XB_TOP], 1u);
            const unsigned tg = og / nx;
            if (og + 1u == (tg + 1u) * nx) xb_add(&bar[XB_TOPGEN], 1u);
            else XB_SPIN(xb_ld(&bar[XB_TOPGEN]) == tg, bar);
            __builtin_amdgcn_fence(__ATOMIC_ACQUIRE, "agent");
            xb_add(&bar[XB_XGEN(b.x)], 1u);
            asm volatile("s_waitcnt vmcnt(0)" ::: "memory");
        } else {
            XB_SPIN(xb_ld(&bar[XB_XGEN(b.x)]) == gen, bar);
            __builtin_amdgcn_fence(__ATOMIC_ACQUIRE, "agent");
            asm volatile("s_waitcnt vmcnt(0)" ::: "memory");
        }
    }
    __syncthreads();
}
__device__ __forceinline__ int crow(int r, int hi) { return (r & 3) + 8 * (r >> 2) + 4 * hi; }
#define ATT_BAR() asm volatile("s_waitcnt lgkmcnt(0)\n\ts_barrier" ::: "memory")
__device__ __forceinline__ void att_wait_vm(int n) {
    if (n >= 8) asm volatile("s_waitcnt vmcnt(8)" ::: "memory"); else if (n == 6) asm volatile("s_waitcnt vmcnt(6)" ::: "memory");
    else if (n == 4) asm volatile("s_waitcnt vmcnt(4)" ::: "memory"); else if (n == 2) asm volatile("s_waitcnt vmcnt(2)" ::: "memory"); else asm volatile("s_waitcnt vmcnt(0)" ::: "memory");
}
constexpr float ATT_THR = 12.0f;
constexpr int ATT_VRING = 65536, ATT_XSTRIDE = 17408;
__device__ __forceinline__ void attn_unit(LAS unsigned char* lds, const bf16_t* Qb, const bf16_t* __restrict__ Kb, const bf16_t* __restrict__ Vt, const bf16_t* __restrict__ Zs,
                                          bf16_t* Ob  , const float* __restrict__ subg, float lam, float oml, int b, int h, int j) {
    int tid = threadIdx.x; asm volatile("" : "+v"(tid));
    const int lane = tid & 63, wid = __builtin_amdgcn_readfirstlane(tid >> 6), sub = wid & 3, map = wid >> 2, r32 = lane & 31, hi = lane >> 5;
    const size_t rowbase = (size_t)b * SEQ, qbase = rowbase + 128 * j;
    const int NT = 2 * j + 3, tmax = 2 * j + 1 + (sub >> 1);
    const bool active = true;
    bf16x8 qf[4];
    { const bf16_t* qsrc = Qb + (qbase + 32 * sub + r32) * DM + h * 128 + map * 64 + hi * 8;
#pragma unroll
      for (int ks = 0; ks < 4; ++ks) qf[ks] = __builtin_nontemporal_load((const bf16x8*)(qsrc + 16 * ks)); }
    const int prow = lane >> 3, pc = lane & 7;
    const int krow = 8 * wid + prow;
    const unsigned koff = (unsigned)(krow * DM + ((pc ^ ((krow >> 1) & 7)) << 3)) * 2u;
    const int vrow0 = 16 * wid + prow, vrow1 = vrow0 + 8;
    const unsigned voff0 = (unsigned)(vrow0 * VP + ((pc ^ ((vrow0 >> 1) & 7)) << 3)) * 2u, voff1 = (unsigned)(vrow1 * VP + ((pc ^ ((vrow1 >> 1) & 7)) << 3)) * 2u;
    const char* kbase = (const char*)(Kb + h * 128);
    const char* vbase = (const char*)(Vt + (size_t)(h * 128) * VP);
#define DMA16(g, off) __builtin_amdgcn_global_load_lds((const unsigned*)(g), (LAS unsigned*)(lds + (off)), 16, 0, 0)
#define TILE_ROW0(t) ((t) == 0 ? (size_t)KM : rowbase + (size_t)((t) - 1) * 64)
#define DMA_K(t, slot) do { const char* kb_ = kbase + TILE_ROW0(t) * (DM * 2); DMA16(kb_ + koff, (slot) * 16384 + wid * 1024); DMA16(kb_ + 128 + koff, (slot) * 16384 + 8192 + wid * 1024); } while (0)
#define DMA_V(t, slot) do { const char* vb_ = vbase + TILE_ROW0(t) * 2; DMA16(vb_ + voff0, ATT_VRING + (slot) * 16384 + wid * 2048); DMA16(vb_ + voff1, ATT_VRING + (slot) * 16384 + wid * 2048 + 1024); } while (0)
    DMA_K(0, 0); DMA_V(0, 0);
    if (NT > 1) { DMA_K(1, 1); DMA_V(1, 1); }
    if (NT > 2) { DMA_K(2, 2); DMA_V(2, 2); }
    if (NT > 3) DMA_K(3, 3);
    const unsigned offk0 = (unsigned)(r32 * 128 + ((hi ^ ((r32 >> 1) & 7)) << 4));
#define OFFK(ks) (offk0 ^ (32u * (ks)))
    f32x16 o[4], s0, s1, negm;
#pragma unroll
    for (int r = 0; r < 16; ++r) { o[0][r] = 0.f; o[1][r] = 0.f; o[2][r] = 0.f; o[3][r] = 0.f; negm[r] = 0.f; }
    float mref = 0.f, lrun = 0.f;
    bf16x8 pf[4];
#define RD128(dst, addr, imm) asm volatile("ds_read_b128 %0, %1 offset:%c2" : "=&v"(dst) : "v"(addr), "i"(imm) : "memory")
#define LW4(n, X) asm volatile("s_waitcnt lgkmcnt(" #n ")" : "+v"(X[0]), "+v"(X[1]), "+v"(X[2]), "+v"(X[3]) :: "memory")
#define SB() __builtin_amdgcn_sched_barrier(0)
#define MF(a, b, c) __builtin_amdgcn_mfma_f32_32x32x16_bf16(a, b, c, 0, 0, 0)
    const unsigned ldsb = (unsigned)(uintptr_t)lds;
    bf16x8 gA[4], gB[4], gC[4];
#define RDV(G, va) do { RD128(G[0], va, 0); RD128(G[1], va, 4096); RD128(G[2], va, 8192); RD128(G[3], va, 12288); } while (0)
#define RDK(G, ka, c0, c1) do { RD128(G[0], ka + OFFK(c0), 0); RD128(G[1], ka + OFFK(c0), 4096); RD128(G[2], ka + OFFK(c1), 0); RD128(G[3], ka + OFFK(c1), 4096); } while (0)
#define PV4(G, p) do { o[0] = MF(G[0], p, o[0]); o[1] = MF(G[1], p, o[1]); o[2] = MF(G[2], p, o[2]); o[3] = MF(G[3], p, o[3]); SB(); } while (0)
#define ATT_S0() do { const unsigned ka_ = ldsb + map * 8192; \
        RDK(gA, ka_, 0, 1); RDK(gB, ka_, 2, 3); \
        LW4(4, gA); s0 = MF(gA[0], qf[0], negm); s1 = MF(gA[1], qf[0], negm); s0 = MF(gA[2], qf[1], s0); s1 = MF(gA[3], qf[1], s1); SB(); \
        LW4(0, gB); s0 = MF(gB[0], qf[2], s0); s1 = MF(gB[1], qf[2], s1); s0 = MF(gB[2], qf[3], s0); s1 = MF(gB[3], qf[3], s1); SB(); } while (0)
#define ATT_ISSUE(vslot) do { const unsigned vb_ = ldsb + ATT_VRING + (vslot) * 16384; \
        RDV(gA, vb_ + OFFK(0)); RDV(gB, vb_ + OFFK(1)); RDV(gC, vb_ + OFFK(2)); } while (0)
#define ATT_CONSUME(vslot, kslot, DO_S) do { const unsigned vb_ = ldsb + ATT_VRING + (vslot) * 16384, ka_ = ldsb + (kslot) * 16384 + map * 8192; \
        LW4(8, gA); PV4(gA, pf[0]); RDV(gA, vb_ + OFFK(3)); \
        if (DO_S) { \
            LW4(8, gB); PV4(gB, pf[1]); RDK(gB, ka_, 0, 1); \
            LW4(8, gC); PV4(gC, pf[2]); RDK(gC, ka_, 2, 3); \
            LW4(8, gA); PV4(gA, pf[3]); \
            LW4(4, gB); s0 = MF(gB[0], qf[0], negm); s1 = MF(gB[1], qf[0], negm); s0 = MF(gB[2], qf[1], s0); s1 = MF(gB[3], qf[1], s1); SB(); \
            LW4(0, gC); s0 = MF(gC[0], qf[2], s0); s1 = MF(gC[1], qf[2], s1); s0 = MF(gC[2], qf[3], s0); s1 = MF(gC[3], qf[3], s1); SB(); \
        } else { LW4(8, gB); PV4(gB, pf[1]); LW4(4, gC); PV4(gC, pf[2]); LW4(0, gA); PV4(gA, pf[3]); } } while (0)
#define MAX3(a, b, c) ({ float r_; asm("v_max3_f32 %0, %1, %2, %3" : "=v"(r_) : "v"(a), "v"(b), "v"(c)); r_; })
#define ATT_SOFTMAX(first) do { \
        asm volatile("s_nop 15\n\ts_nop 7" : "+v"(s0), "+v"(s1));                 \
        float ma_ = MAX3(s0[0], s0[1], s0[2]), mb_ = MAX3(s0[3], s0[4], s0[5]); \
        ma_ = MAX3(ma_, s0[6], s0[7]); mb_ = MAX3(mb_, s0[8], s0[9]); ma_ = MAX3(ma_, s0[10], s0[11]); mb_ = MAX3(mb_, s0[12], s0[13]); ma_ = MAX3(ma_, s0[14], s0[15]); \
        mb_ = MAX3(mb_, s1[0], s1[1]); ma_ = MAX3(ma_, s1[2], s1[3]); mb_ = MAX3(mb_, s1[4], s1[5]); ma_ = MAX3(ma_, s1[6], s1[7]); \
        mb_ = MAX3(mb_, s1[8], s1[9]); ma_ = MAX3(ma_, s1[10], s1[11]); mb_ = MAX3(mb_, s1[12], s1[13]); ma_ = MAX3(ma_, s1[14], s1[15]); \
        float mx_ = MAX3(ma_, mb_, mb_); \
        { auto rr_ = __builtin_amdgcn_permlane32_swap(__float_as_uint(mx_), __float_as_uint(mx_), false, false); const float x0_ = __uint_as_float(rr_[0]), x1_ = __uint_as_float(rr_[1]); mx_ = MAX3(x0_, x1_, x1_); } \
        if (first) { mref = mx_; \
            _Pragma("unroll") for (int r = 0; r < 16; ++r) { s0[r] -= mx_; s1[r] -= mx_; negm[r] = -mref; } } \
        else if (__any(mx_ > ATT_THR)) { \
            const float dl_ = (mx_ > 0.f) ? mx_ : 0.f; const float al_ = fast_exp2(-dl_); mref += dl_; lrun *= al_; \
            _Pragma("unroll") for (int r = 0; r < 16; ++r) { s0[r] -= dl_; s1[r] -= dl_; negm[r] = -mref; } \
            _Pragma("unroll") for (int eb = 0; eb < 4; ++eb) _Pragma("unroll") for (int r = 0; r < 16; ++r) o[eb][r] *= al_; } \
        float ls_ = 0.f; \
        _Pragma("unroll") for (int r = 0; r < 16; ++r) { s0[r] = fast_exp2(s0[r]); s1[r] = fast_exp2(s1[r]); ls_ += s0[r] + s1[r]; } \
        lrun += ls_; \
        _Pragma("unroll") for (int s = 0; s < 2; ++s) { u32x4 w_; \
            w_.x = cvt_pk_bf16(s0[8 * s + 0], s0[8 * s + 1]); w_.y = cvt_pk_bf16(s0[8 * s + 2], s0[8 * s + 3]); w_.z = cvt_pk_bf16(s0[8 * s + 4], s0[8 * s + 5]); w_.w = cvt_pk_bf16(s0[8 * s + 6], s0[8 * s + 7]); \
            pf[s] = __builtin_bit_cast(bf16x8, w_); \
            w_.x = cvt_pk_bf16(s1[8 * s + 0], s1[8 * s + 1]); w_.y = cvt_pk_bf16(s1[8 * s + 2], s1[8 * s + 3]); w_.z = cvt_pk_bf16(s1[8 * s + 4], s1[8 * s + 5]); w_.w = cvt_pk_bf16(s1[8 * s + 6], s1[8 * s + 7]); \
            pf[2 + s] = __builtin_bit_cast(bf16x8, w_); } } while (0)
#define ADDF(a, b) ({ float r_; asm("v_add_f32 %0, %1, %2" : "=v"(r_) : "v"(a), "v"(b)); r_; })
#define SUM8(X, b) ADDF(ADDF(ADDF(X[b], X[b + 1]), ADDF(X[b + 2], X[b + 3])), ADDF(ADDF(X[b + 4], X[b + 5]), ADDF(X[b + 6], X[b + 7])))
#define EX4(X, b) do { X[b] = fast_exp2(X[b]); X[b + 1] = fast_exp2(X[b + 1]); X[b + 2] = fast_exp2(X[b + 2]); X[b + 3] = fast_exp2(X[b + 3]); } while (0)
#define CV8(dst, X, b) do { u32x4 w_; w_.x = cvt_pk_bf16(X[b], X[b + 1]); w_.y = cvt_pk_bf16(X[b + 2], X[b + 3]); w_.z = cvt_pk_bf16(X[b + 4], X[b + 5]); w_.w = cvt_pk_bf16(X[b + 6], X[b + 7]); dst = __builtin_bit_cast(bf16x8, w_); } while (0)
#define ATT_UNI(vslot, kslot) do { const unsigned vb_ = ldsb + ATT_VRING + (vslot) * 16384, ka_ = ldsb + (kslot) * 16384 + map * 8192; \
        RDK(gA, ka_, 0, 1); RDK(gB, ka_, 2, 3); RDV(gC, vb_ + OFFK(0)); \
        __builtin_amdgcn_s_setprio(2); \
        LW4(8, gA); s0 = MF(gA[0], qf[0], negm); s1 = MF(gA[1], qf[0], negm); s0 = MF(gA[2], qf[1], s0); s1 = MF(gA[3], qf[1], s1); SB(); \
        RDV(gA, vb_ + OFFK(1)); \
        LW4(8, gB); s0 = MF(gB[0], qf[2], s0); s1 = MF(gB[1], qf[2], s1); s0 = MF(gB[2], qf[3], s0); s1 = MF(gB[3], qf[3], s1); SB(); \
        RDV(gB, vb_ + OFFK(2)); \
        __builtin_amdgcn_s_setprio(0); \
        LW4(8, gC); o[0] = MF(gC[0], pf[0], o[0]); o[1] = MF(gC[1], pf[0], o[1]); SB(); \
        asm volatile("s_nop 15\n\ts_nop 7" : "+v"(s0), "+v"(s1)); \
        float ma_ = MAX3(s0[0], s0[1], s0[2]), mb_ = MAX3(s0[3], s0[4], s0[5]); ma_ = MAX3(ma_, s0[6], s0[7]); mb_ = MAX3(mb_, s0[8], s0[9]); SB(); \
        o[2] = MF(gC[2], pf[0], o[2]); SB(); \
        ma_ = MAX3(ma_, s0[10], s0[11]); mb_ = MAX3(mb_, s0[12], s0[13]); ma_ = MAX3(ma_, s0[14], s0[15]); mb_ = MAX3(mb_, s1[0], s1[1]); ma_ = MAX3(ma_, s1[2], s1[3]); mb_ = MAX3(mb_, s1[4], s1[5]); SB(); \
        o[3] = MF(gC[3], pf[0], o[3]); SB(); \
        RDV(gC, vb_ + OFFK(3)); \
        ma_ = MAX3(ma_, s1[6], s1[7]); mb_ = MAX3(mb_, s1[8], s1[9]); ma_ = MAX3(ma_, s1[10], s1[11]); mb_ = MAX3(mb_, s1[12], s1[13]); ma_ = MAX3(ma_, s1[14], s1[15]); \
        float mx_ = MAX3(ma_, mb_, mb_); \
        { auto rr_ = __builtin_amdgcn_permlane32_swap(__float_as_uint(mx_), __float_as_uint(mx_), false, false); const float x0_ = __uint_as_float(rr_[0]), x1_ = __uint_as_float(rr_[1]); mx_ = MAX3(x0_, x1_, x1_); } \
        float alp_ = 1.0f; const bool resc_ = __any(mx_ > ATT_THR); \
        if (resc_) { const float dl_ = (mx_ > 0.f) ? mx_ : 0.f; alp_ = fast_exp2(-dl_); mref += dl_; lrun *= alp_; \
            _Pragma("unroll") for (int r = 0; r < 16; ++r) { s0[r] -= dl_; s1[r] -= dl_; negm[r] = -mref; } } \
        SB(); \
        LW4(8, gA); o[0] = MF(gA[0], pf[1], o[0]); SB(); EX4(s0, 0); SB(); o[1] = MF(gA[1], pf[1], o[1]); SB(); EX4(s0, 4); SB(); \
        o[2] = MF(gA[2], pf[1], o[2]); SB(); EX4(s0, 8); SB(); o[3] = MF(gA[3], pf[1], o[3]); SB(); EX4(s0, 12); SB(); \
        LW4(4, gB); o[0] = MF(gB[0], pf[2], o[0]); SB(); EX4(s1, 0); SB(); o[1] = MF(gB[1], pf[2], o[1]); SB(); EX4(s1, 4); SB(); \
        o[2] = MF(gB[2], pf[2], o[2]); SB(); EX4(s1, 8); SB(); o[3] = MF(gB[3], pf[2], o[3]); SB(); EX4(s1, 12); SB(); \
        bf16x8 pn0_, pn1_, pn2_, pn3_; float ls_; \
        LW4(0, gC); o[0] = MF(gC[0], pf[3], o[0]); SB(); \
        ls_ = SUM8(s0, 0); CV8(pn0_, s0, 0); SB(); \
        o[1] = MF(gC[1], pf[3], o[1]); SB(); \
        ls_ = ADDF(ls_, SUM8(s0, 8)); CV8(pn1_, s0, 8); SB(); \
        o[2] = MF(gC[2], pf[3], o[2]); SB(); \
        ls_ = ADDF(ls_, SUM8(s1, 0)); CV8(pn2_, s1, 0); SB(); \
        o[3] = MF(gC[3], pf[3], o[3]); SB(); \
        ls_ = ADDF(ls_, SUM8(s1, 8)); CV8(pn3_, s1, 8); SB(); \
        lrun += ls_; pf[0] = pn0_; pf[1] = pn1_; pf[2] = pn2_; pf[3] = pn3_; \
        if (resc_) { _Pragma("unroll") for (int eb = 0; eb < 4; ++eb) _Pragma("unroll") for (int r = 0; r < 16; ++r) o[eb][r] *= alp_; } } while (0)
    if (NT > 3) __builtin_amdgcn_s_waitcnt(0x0F7C); else __builtin_amdgcn_s_waitcnt(0x0F70);
    ATT_BAR();
    if (active) {
        ATT_S0();
#pragma unroll
        for (int r = 0; r < 16; ++r) s0[r] = -INFINITY;
#pragma unroll
        for (int r = 0; r < 8; ++r) s1[r] = -INFINITY;
        ATT_SOFTMAX(true);
    }
    att_wait_vm((NT > 3 ? 2 : 0) + (NT > 2 ? 4 : 0) + (NT > 1 ? 2 : 0));
    int k3 = 0;
#define ATT_HEAD(k) ATT_BAR();                             \
        const int k3p1 = (k3 + 1) & 3; \
        if ((k) + 4 < NT) DMA_K((k) + 4, k3);              \
        if ((k) + 3 < NT) DMA_V((k) + 3, (k3 + 3) & 3);
#define ATT_TAIL(k) att_wait_vm(((k) + 4 < NT ? 2 : 0) + ((k) + 3 < NT ? 4 : 0) + ((k) + 2 < NT ? 2 : 0));     \
        k3 = k3p1;
    for (int k = 0; k < tmax; ++k) {
        ATT_HEAD(k)
        ATT_UNI(k3, k3p1);
        ATT_TAIL(k)
    }
    { ATT_HEAD(tmax)
      ATT_ISSUE(k3);
      ATT_CONSUME(k3, k3p1, false);
      ATT_TAIL(tmax) }
    if (tmax < NT - 1) { ATT_BAR(); att_wait_vm(0); }
#undef ATT_HEAD
#undef ATT_TAIL
#undef DMA16
#undef TILE_ROW0
#undef OFFK
#undef DMA_K
#undef DMA_V
#undef ATT_S0
#undef ATT_ISSUE
#undef ATT_CONSUME
#undef PV4
#undef RDV
#undef RDK
#undef RD128
#undef LW4
#undef SB
#undef MF
#undef ATT_SOFTMAX
#undef MAX3
#undef ATT_UNI
#undef EX4
#undef ADDF
#undef SUM8
#undef CV8
    { auto rr = __builtin_amdgcn_permlane32_swap(__float_as_uint(lrun), __float_as_uint(lrun), false, false); lrun = __uint_as_float(rr[0]) + __uint_as_float(rr[1]); }
    const float inv = 1.0f / lrun;
    LAS float* ex = (LAS float*)(lds + sub * ATT_XSTRIDE);
    const int e0 = (lane & 15) * 8;
    u32x4 zreg[8]; f32x4 ga, gb;
    if (map == 0) {
        ga = *(const f32x4*)(subg + e0); gb = *(const f32x4*)(subg + e0 + 4);
#pragma unroll
        for (int ps = 0; ps < 8; ++ps) zreg[ps] = __builtin_nontemporal_load((const u32x4*)(Zs + (qbase + 32 * sub + ps * 4 + (lane >> 4)) * DM + h * 128 + e0));
    }
    ATT_BAR();
    if (active && map == 1) {
        const float f = inv * lam;
#pragma unroll
        for (int eb = 0; eb < 4; ++eb)
#pragma unroll
            for (int rq = 0; rq < 4; ++rq) { f32x4 v; v[0] = o[eb][4 * rq] * f; v[1] = o[eb][4 * rq + 1] * f; v[2] = o[eb][4 * rq + 2] * f; v[3] = o[eb][4 * rq + 3] * f;
                *(LAS f32x4*)(ex + r32 * 132 + 32 * eb + 8 * rq + 4 * hi) = v; }
    }
    ATT_BAR();
    if (active && map == 0) {
        float ssq = 0.f;
#pragma unroll
        for (int eb = 0; eb < 4; ++eb)
#pragma unroll
            for (int rq = 0; rq < 4; ++rq) { const f32x4 x = *(const LAS f32x4*)(ex + r32 * 132 + 32 * eb + 8 * rq + 4 * hi);
#pragma unroll
                for (int j = 0; j < 4; ++j) { const float v = o[eb][4 * rq + j] * inv - x[j]; o[eb][4 * rq + j] = v; ssq += v * v; } }
        { auto rr = __builtin_amdgcn_permlane32_swap(__float_as_uint(ssq), __float_as_uint(ssq), false, false); ssq = __uint_as_float(rr[0]) + __uint_as_float(rr[1]); }
        const float rn = rsqrtf(ssq * (1.0f / 128.0f) + EPS) * oml;
#pragma unroll
        for (int eb = 0; eb < 4; ++eb)
#pragma unroll
            for (int rq = 0; rq < 4; ++rq) { f32x4 v; v[0] = o[eb][4 * rq] * rn; v[1] = o[eb][4 * rq + 1] * rn; v[2] = o[eb][4 * rq + 2] * rn; v[3] = o[eb][4 * rq + 3] * rn;
                *(LAS f32x4*)(ex + r32 * 132 + 32 * eb + 8 * rq + 4 * hi) = v; }
        asm volatile("s_waitcnt lgkmcnt(0)" ::: "memory");
#pragma unroll
        for (int ps = 0; ps < 8; ++ps) {
            const int q = ps * 4 + (lane >> 4);
            const size_t row = qbase + 32 * sub + q;
            const f32x4 xa = *(const LAS f32x4*)(ex + q * 132 + e0), xb = *(const LAS f32x4*)(ex + q * 132 + e0 + 4);
            const u32x4 z = zreg[ps];
            u32x4 w;
            w.x = cvt_pk_bf16(xa[0] * ga[0] * bf_lo(z.x), xa[1] * ga[1] * bf_hi(z.x)); w.y = cvt_pk_bf16(xa[2] * ga[2] * bf_lo(z.y), xa[3] * ga[3] * bf_hi(z.y));
            w.z = cvt_pk_bf16(xb[0] * gb[0] * bf_lo(z.z), xb[1] * gb[1] * bf_hi(z.z)); w.w = cvt_pk_bf16(xb[2] * gb[2] * bf_lo(z.w), xb[3] * gb[3] * bf_hi(z.w));
            *(u32x4*)(Ob + row * DM + h * 128 + e0) = w;
        }
    }
    ATT_BAR();
}
__device__ __forceinline__ void attn_phase(LAS unsigned char* lds, const bf16_t* Qb, const bf16_t* Kb, const bf16_t* Vt, const bf16_t* Zs, bf16_t* Ob, const float* subg, float lam, float oml, int vcu, int G) {
    for (int P = vcu; P < 1024; P += G) {
        const int bh = P >> 3, s = P & 7;
        for (int u = 0; u < 2; ++u) attn_unit(lds, Qb, Kb, Vt, Zs, Ob, subg, lam, oml, bh >> 3, bh & 7, u ? 15 - s : s);
    }
}
struct Args {
    const float *x, *meta, *a_norm_g, *a_w_in, *a_conv_w, *a_conv_b, *a_w_out, *kv_norm_g, *w_kv, *b_norm_g, *b_w_in, *lq1, *lk1, *lq2, *lk2, *subln_g, *b_w_out, *final_g;
    float* out; unsigned char* ws;
};
struct TrItem { const float* src; const float* g; bf16_t* dst; int N; };
__device__ __forceinline__ TrItem tr_decode(const Args& a, int it, int lane) {
    unsigned char* ws = a.ws;
    constexpr int I_AIN = 16 * 64, I_SQ = 16 * 16, I_BIN = 16 * 32;
    const float* W; const float* g; bf16_t* WT; int N, col_off = 0, row_off = 0, nblk; bool perma = false;
    int r = it;
    if (r < 2 * I_AIN) { const int l = r / I_AIN; r -= l * I_AIN; W = a.a_w_in + (size_t)l * DM * 4096; N = 4096; g = a.a_norm_g + l * DM; WT = (bf16_t*)(ws + WS_WAIN) + (size_t)l * 4096 * DM; nblk = 64; perma = true; }
    else { r -= 2 * I_AIN;
    if (r < 2 * I_SQ) { const int l = r / I_SQ; r -= l * I_SQ; W = a.a_w_out + (size_t)l * DM * DM; N = DM; g = nullptr; WT = (bf16_t*)(ws + WS_WAOUT) + (size_t)l * DM * DM; nblk = 16; }
    else { r -= 2 * I_SQ;
    if (r < I_SQ) { W = a.w_kv; N = 2048; g = a.kv_norm_g; WT = (bf16_t*)(ws + WS_WKQZ); nblk = 16; }
    else { r -= I_SQ;
    if (r < I_SQ) { W = a.w_kv; N = 2048; col_off = 1024; g = a.kv_norm_g; WT = (bf16_t*)(ws + WS_WVT); nblk = 16; }
    else { r -= I_SQ;
    if (r < I_BIN) { W = a.b_w_in; N = 2048; g = a.b_norm_g; WT = (bf16_t*)(ws + WS_WKQZ); row_off = 1024; nblk = 32; }
    else { r -= I_BIN;
    if (r < I_BIN) { W = a.b_w_in + (size_t)DM * 2048; N = 2048; g = a.b_norm_g + DM; WT = (bf16_t*)(ws + WS_WQZ1); nblk = 32; }
    else { r -= I_BIN; const int l = r / I_SQ; r -= l * I_SQ; W = a.b_w_out + (size_t)l * DM * DM; N = DM; g = nullptr; WT = (bf16_t*)(ws + WS_WBOUT) + (size_t)l * DM * DM; nblk = 16; } } } } } }
    const int kb = r / nblk, nb = r - kb * nblk, k0 = 64 * kb, n0 = 64 * nb, nq = lane & 15, kr = lane >> 4;
    const int np = n0 + 4 * nq; int src;
    if (perma) { const int pn = np >> 8, bj = (np >> 7) & 1, wc = (np >> 5) & 3, nn = (np >> 4) & 1, low = np & 15; src = (2 * bj + nn) * 1024 + 64 * pn + 16 * wc + low; }
    else src = col_off + np;
    TrItem t; t.src = W + (size_t)(k0 + kr) * N + src; t.g = g ? g + k0 : nullptr; t.dst = WT + (size_t)(row_off + n0) * DM + k0; t.N = N;
    return t;
}
__device__ __forceinline__ void tr_load(const TrItem& t, f32x4 (&v)[16]) {
#pragma unroll
    for (int i = 0; i < 16; ++i) v[i] = __builtin_nontemporal_load((const f32x4*)(t.src + (size_t)(4 * i) * t.N));
}
__device__ __forceinline__ void tr_store(const TrItem& t, const f32x4 (&v)[16], LAS float* scr, int lane) {
    const int nq = lane & 15, kr = lane >> 4;
#pragma unroll
    for (int i = 0; i < 16; ++i) { const int kk = 4 * i + kr; const float gg = t.g ? t.g[kk] : 1.0f;
        scr[kk * 65 + 4 * nq + 0] = v[i][0] * gg; scr[kk * 65 + 4 * nq + 1] = v[i][1] * gg; scr[kk * 65 + 4 * nq + 2] = v[i][2] * gg; scr[kk * 65 + 4 * nq + 3] = v[i][3] * gg; }
    asm volatile("s_waitcnt lgkmcnt(0)" ::: "memory");
    const int c = lane & 7;
#pragma unroll
    for (int j = 0; j < 8; ++j) { const int n = (lane >> 3) + 8 * j; const LAS float* s = scr + (8 * c) * 65 + n;
        u32x4 o; o.x = cvt_pk_bf16(s[0 * 65], s[1 * 65]); o.y = cvt_pk_bf16(s[2 * 65], s[3 * 65]); o.z = cvt_pk_bf16(s[4 * 65], s[5 * 65]); o.w = cvt_pk_bf16(s[6 * 65], s[7 * 65]);
        *(u32x4*)(t.dst + (size_t)n * DM + 8 * c) = o; }
    asm volatile("s_waitcnt lgkmcnt(0)" ::: "memory");
}
__device__ __forceinline__ void prologue(const Args& a, LAS unsigned char* lds, int gw, int NGW, int wave, int lane) {
    LAS float* scr = (LAS float*)(lds + wave * 16640);
    unsigned char* ws = a.ws;
    constexpr int NITEMS = 2 * (16 * 64) + 2 * 256 + 2 * 256 + 2 * (16 * 32) + 2 * 256;
    if (gw < NITEMS) {
        TrItem cur = tr_decode(a, gw, lane); f32x4 v[16]; tr_load(cur, v);
        for (int it = gw; it < NITEMS; it += NGW) {
            const bool more = it + NGW < NITEMS;
            TrItem nxt = cur; f32x4 vn[16];
            if (more) { nxt = tr_decode(a, it + NGW, lane); tr_load(nxt, vn); }
            tr_store(cur, v, scr, lane);
            if (more) { cur = nxt;
#pragma unroll
                for (int i = 0; i < 16; ++i) v[i] = vn[i]; }
        }
    }
    bf16_t* hb = (bf16_t*)(ws + WS_HB); float* part = (float*)(ws + WS_SS);
#define H0_LOAD(dst, r0) do { _Pragma("unroll") for (int q = 0; q < 4; ++q) { const int row_ = (r0) + q; const float* src_ = (row_ < MF) ? a.x + (size_t)row_ * DM : a.meta + (size_t)(row_ - MF) * DM; \
        _Pragma("unroll") for (int j = 0; j < 4; ++j) dst[q][j] = __builtin_nontemporal_load((const f32x4*)(src_ + 4 * lane + 256 * j)); } } while (0)
    if (gw * 4 < MF + NMETA) {
        f32x4 v[4][4]; H0_LOAD(v, gw * 4);
        for (int row0 = gw * 4; row0 < MF + NMETA; row0 += NGW * 4) {
            const bool more = row0 + NGW * 4 < MF + NMETA;
            f32x4 vn[4][4];
            if (more) H0_LOAD(vn, row0 + NGW * 4);
#pragma unroll
            for (int q = 0; q < 4; ++q) { const int row = row0 + q; float ss = 0.f;
#pragma unroll
                for (int j = 0; j < 4; ++j) { const f32x4 x = v[q][j];
                    ss += (x[0] * x[0] + x[1] * x[1]) + (x[2] * x[2] + x[3] * x[3]);
                    u32x2 w; w.x = cvt_pk_bf16(x[0], x[1]); w.y = cvt_pk_bf16(x[2], x[3]);
                    *(u32x2*)(hb + (size_t)row * DM + 4 * lane + 256 * j) = w; }
                ss = wave_sum(ss);
                if (lane < 16) part[(size_t)row * 16 + lane] = (lane == 0) ? ss : 0.f; }
            if (more) {
#pragma unroll
                for (int q = 0; q < 4; ++q)
#pragma unroll
                    for (int j = 0; j < 4; ++j) v[q][j] = vn[q][j]; }
        }
    }
#undef H0_LOAD
}
__device__ __forceinline__ void conv_phase(const bf16_t* __restrict__ v, const bf16_t* __restrict__ gz, bf16_t* __restrict__ y, const float* __restrict__ cw, const float* __restrict__ cb, int bid, int G, int tid) {
    const int cg8 = (tid & 127) * 8, rsub = tid >> 7;
    float w0[8], w1[8], w2[8], bb[8];
#pragma unroll
    for (int i = 0; i < 8; ++i) { w0[i] = cw[cg8 + i]; w1[i] = cw[DM + cg8 + i]; w2[i] = cw[2 * DM + cg8 + i]; bb[i] = cb[cg8 + i]; }
    for (int i = bid * 4 + rsub; i < MF / 32 + NMETA; i += G * 4) {
        const int r = (i < MF / 32) ? (i >> 1) * 64 + (i & 1) : MF + (i - MF / 32);
        int r1, r2;
        if (r < MF) { const int t = r & (SEQ - 1); r1 = (t >= 1) ? r - 1 : HM + 15; r2 = (t >= 2) ? r - 2 : HM + 14 + t; }
        else { const int mm = r - MF; r1 = (mm >= 1) ? r - 1 : -1; r2 = (mm >= 2) ? r - 2 : -1; }
        const u32x4 zero = (u32x4){0u, 0u, 0u, 0u};
        const u32x4 a0 = *(const u32x4*)(v + (size_t)r * DM + cg8);
        const u32x4 a1 = (r1 >= 0) ? *(const u32x4*)(v + (size_t)r1 * DM + cg8) : zero;
        const u32x4 a2 = (r2 >= 0) ? *(const u32x4*)(v + (size_t)r2 * DM + cg8) : zero;
        const u32x4 gg = *(const u32x4*)(gz + (size_t)r * DM + cg8);
        float o[8];
#pragma unroll
        for (int i = 0; i < 4; ++i) {
            const unsigned x0 = a0[i], x1 = a1[i], x2 = a2[i], gx = gg[i];
            o[2 * i] = bf_lo(gx) * (w0[2 * i] * bf_lo(x2) + w1[2 * i] * bf_lo(x1) + w2[2 * i] * bf_lo(x0) + bb[2 * i]);
            o[2 * i + 1] = bf_hi(gx) * (w0[2 * i + 1] * bf_hi(x2) + w1[2 * i + 1] * bf_hi(x1) + w2[2 * i + 1] * bf_hi(x0) + bb[2 * i + 1]);
        }
        u32x4 w; w.x = cvt_pk_bf16(o[0], o[1]); w.y = cvt_pk_bf16(o[2], o[3]); w.z = cvt_pk_bf16(o[4], o[5]); w.w = cvt_pk_bf16(o[6], o[7]);
        *(u32x4*)(y + (size_t)r * DM + cg8) = w;
    }
}
__device__ __forceinline__ void final_phase(const bf16_t* __restrict__ hb, const float* __restrict__ part, const float* __restrict__ fg, float* __restrict__ out, int gw, int NGW, int lane) {
    f32x4 g[4];
#pragma unroll
    for (int j = 0; j < 2; ++j) { g[2 * j] = *(const f32x4*)(fg + 8 * lane + 512 * j); g[2 * j + 1] = *(const f32x4*)(fg + 8 * lane + 512 * j + 4); }
    for (int orow = gw; orow < MF; orow += NGW) {
        const size_t row = (size_t)orow;
        float s = part[row * 16 + (lane & 15)];
        s += __shfl_xor(s, 1); s += __shfl_xor(s, 2); s += __shfl_xor(s, 4); s += __shfl_xor(s, 8);
        const float rs = rsqrtf(s * (1.0f / DM) + EPS);
#pragma unroll
        for (int j = 0; j < 2; ++j) {
            const u32x4 hv = __builtin_nontemporal_load((const u32x4*)(hb + row * DM + 8 * lane + 512 * j));
            f32x4 o0, o1;
            o0[0] = bf_lo(hv.x) * rs * g[2 * j][0]; o0[1] = bf_hi(hv.x) * rs * g[2 * j][1]; o0[2] = bf_lo(hv.y) * rs * g[2 * j][2]; o0[3] = bf_hi(hv.y) * rs * g[2 * j][3];
            o1[0] = bf_lo(hv.z) * rs * g[2 * j + 1][0]; o1[1] = bf_hi(hv.z) * rs * g[2 * j + 1][1]; o1[2] = bf_lo(hv.w) * rs * g[2 * j + 1][2]; o1[3] = bf_hi(hv.w) * rs * g[2 * j + 1][3];
            __builtin_nontemporal_store(o0, (f32x4*)(out + (size_t)orow * DM + 8 * lane + 512 * j)); __builtin_nontemporal_store(o1, (f32x4*)(out + (size_t)orow * DM + 8 * lane + 512 * j + 4));
        }
    }
}
typedef const __attribute__((address_space(4))) Args* CArgsP;
#define AP() ({ CArgsP p_ = (CArgsP)__builtin_amdgcn_kernarg_segment_ptr(); asm volatile("" : "+s"(p_)); p_; })
#define WSB(off) ((bf16_t*)(ws + (off)))
#define GRID_BAR() do { XcdBarrier bb_; bb_.bar = (unsigned*)(AP()->ws + WS_CTL); bb_.x = xb_xcc_id(); bb_.st = (volatile LAS unsigned*)(lds + 131072 + 128); xcd_barrier(bb_); } while (0)
__global__ void __launch_bounds__(512, 2) yoco_fwd(Args a_unused) {
    extern __shared__ __attribute__((aligned(16))) unsigned char lds_raw[];
    LAS unsigned char* lds = (LAS unsigned char*)lds_raw;
    cg::grid_group grid = cg::this_grid();
    const int G = gridDim.x, bx = blockIdx.x;
    const int vcu = (G % 8 == 0) ? (bx % 8) * (G / 8) + bx / 8 : bx;
    {
        CArgsP ap = AP(); unsigned char* ws = ap->ws;
        int tid = threadIdx.x; asm volatile("" : "+v"(tid));
        const int lane = tid & 63, wave = __builtin_amdgcn_readfirstlane(tid >> 6);
        if (bx == 0) { for (int i = tid; i < 4096; i += 512) ((unsigned*)(ws + WS_CTL))[i] = 0u; }
        Args acopy; { const __attribute__((address_space(4))) unsigned long long* s_ = (const __attribute__((address_space(4))) unsigned long long*)ap; unsigned long long* d_ = (unsigned long long*)&acopy;
#pragma unroll
          for (int i = 0; i < (int)(sizeof(Args) / 8); ++i) d_[i] = s_[i]; }
        prologue(acopy, lds, vcu * 8 + wave, G * 8, wave, lane);
        __syncthreads();
        if (tid < 2) ((volatile LAS unsigned*)(lds + 131072 + 128))[tid] = 0u;
    }
    grid.sync();
    if (threadIdx.x == 0) { const unsigned r_ = xb_add((unsigned*)(AP()->ws + WS_CTL) + XB_XCNT(xb_xcc_id()), 1u); ((volatile LAS unsigned*)(lds + 131072 + 128))[2] = r_; }
    __syncthreads();
#define REAL_CU(out_c, out_v) do { unsigned* bar_ = (unsigned*)(AP()->ws + WS_CTL); bool ok_ = (G % 8 == 0); \
        for (int j_ = 0; j_ < 8; ++j_) ok_ = ok_ && (xb_ld(&bar_[XB_XCNT(j_)]) == (unsigned)(G / 8)); \
        const int x_ = (int)xb_xcc_id(), r_ = (int)((volatile LAS unsigned*)(lds + 131072 + 128))[2]; \
        ok_ = ok_ && x_ < 8 && r_ < G / 8; \
        out_c = ok_ ? r_ * 8 + x_ : bx;                   \
        out_v = ok_ ? x_ * (G / 8) + r_ : vcu;            \
        out_c = __builtin_amdgcn_readfirstlane(out_c); out_v = __builtin_amdgcn_readfirstlane(out_v); } while (0)
#pragma unroll 1
    for (int layer = 0; layer < 4; ++layer) {
        if (layer < 2) {
            { CArgsP ap = AP(); unsigned char* ws = ap->ws; bf16_t* hb = WSB(WS_HB); float* part = (float*)(ws + WS_SS);
              const bf16_t* Wl = WSB(WS_WAIN) + (size_t)layer * 4096 * DM;
              int t2 = threadIdx.x; asm volatile("" : "+v"(t2));
              if (vcu < 64) meta_ain_job(vcu, hb, Wl, part, WSB(WS_BUF0), WSB(WS_BUF1), __builtin_amdgcn_readfirstlane(t2 >> 6), t2 & 63, lds);
              pg8::Gemm g{hb, Wl, MF, 4096, DM}; pg8::StaticOrder S; S.init(MF, 4096, G, bx);
              EpiAIn E{part, WSB(WS_BUF0), WSB(WS_BUF1), WSB(WS_BUF2), ap->a_conv_w + (size_t)layer * 3 * DM, ap->a_conv_b + (size_t)layer * DM};
              pg8::gemm_phase<EpiAIn, pg8::StaticOrder, true, true>(lds, g, S, E); }
            GRID_BAR();
            { CArgsP ap = AP(); unsigned char* ws = ap->ws; int t2 = threadIdx.x; asm volatile("" : "+v"(t2));
              conv_phase(WSB(WS_BUF0), WSB(WS_BUF1), WSB(WS_BUF2), ap->a_conv_w + (size_t)layer * 3 * DM, ap->a_conv_b + (size_t)layer * DM, bx, G, t2); }
            GRID_BAR();
        } else {
            const int lb = layer - 2;
            if (lb == 0) {
              CArgsP ap = AP(); unsigned char* ws = ap->ws; bf16_t* hb = WSB(WS_HB); float* part = (float*)(ws + WS_SS);
              int t2 = threadIdx.x; asm volatile("" : "+v"(t2)); const int wv = __builtin_amdgcn_readfirstlane(t2 >> 6);
              if (bx == G - 1) { for (int i = t2; i < PADR * DM / 8; i += 512) *(u32x4*)(WSB(WS_BUF0) + (size_t)KM * DM + (size_t)i * 8) = (u32x4){0u, 0u, 0u, 0u}; }
              if (bx == G - 2) { for (int i = t2; i < 1024 * 6; i += 512) *(u32x4*)(WSB(WS_BUF3) + (size_t)(i / 6) * VP + MF + (i % 6) * 8) = (u32x4){0u, 0u, 0u, 0u}; }
              if (vcu < 16) meta_k_job(vcu, hb, WSB(WS_WKQZ), part, WSB(WS_BUF0), wv, t2 & 63, lds);
              else if (vcu < 32) meta_v_job(vcu - 16, hb, WSB(WS_WVT), part, WSB(WS_BUF3), wv, t2 & 63, lds); }
            { CArgsP ap = AP(); unsigned char* ws = ap->ws;
              pg8::Gemm g{WSB(WS_HB), lb ? WSB(WS_WQZ1) : WSB(WS_WKQZ), MF, lb ? 2048 : 3072, DM}; pg8::StaticOrder S; S.init(MF, lb ? 2048 : 3072, G, bx);
              EpiKQZ E{(const float*)(ws + WS_SS), WSB(WS_BUF0), lb ? 1 : 0};
              pg8::gemm_phase<EpiKQZ, pg8::StaticOrder, true, true>(lds, g, S, E); }
            if (lb == 0) {
              CArgsP ap = AP(); unsigned char* ws = ap->ws;
              pg8::Gemm g{WSB(WS_WVT), WSB(WS_HB), DM, MF, DM}; pg8::StaticOrder S; S.init(DM, MF, G, bx);
              EpiVt E{(const float*)(ws + WS_SS), WSB(WS_BUF3)};
              pg8::gemm_phase<EpiVt, pg8::StaticOrder, true, true>(lds, g, S, E); }
            GRID_BAR();
            { CArgsP ap = AP(); unsigned char* ws = ap->ws;
              float lam, oml;
              { int l2 = threadIdx.x; asm volatile("" : "+v"(l2)); l2 &= 63; const float p1 = ap->lq1[lb * 64 + l2] * ap->lk1[lb * 64 + l2], p2 = ap->lq2[lb * 64 + l2] * ap->lk2[lb * 64 + l2];
                const float li = 0.8f - 0.6f * expf(-0.3f * (float)layer);
                lam = expf(wave_sum(p1)) - expf(wave_sum(p2)) + li; oml = 1.0f - li;
                lam = __uint_as_float(__builtin_amdgcn_readfirstlane(__float_as_uint(lam))); oml = __uint_as_float(__builtin_amdgcn_readfirstlane(__float_as_uint(oml))); }
              int rc_, rv_; REAL_CU(rc_, rv_);
              attn_phase(lds, WSB(WS_BUF1), WSB(WS_BUF0), WSB(WS_BUF3), WSB(WS_BUF2), WSB(WS_BUF1), ap->subln_g + lb * 128, lam, oml, rv_, G); }
            GRID_BAR();
        }
        { CArgsP ap = AP(); unsigned char* ws = ap->ws; bf16_t* hb = WSB(WS_HB); float* part = (float*)(ws + WS_SS);
          const bf16_t* Aout = (layer < 2) ? WSB(WS_BUF2) : WSB(WS_BUF1);
          const bf16_t* Wout = (layer < 2) ? WSB(WS_WAOUT) + (size_t)layer * DM * DM : WSB(WS_WBOUT) + (size_t)(layer - 2) * DM * DM;
          int t2 = threadIdx.x; asm volatile("" : "+v"(t2));
          if (layer < 2 && vcu < 16) meta_res_job(vcu, Aout, Wout, hb, part, __builtin_amdgcn_readfirstlane(t2 >> 6), t2 & 63, lds);
          pg8::Gemm g{Aout, Wout, MF, DM, DM}; pg8::StaticOrder S; S.init(MF, DM, G, bx);
          EpiRes E{hb, part};
          pg8::gemm_phase<EpiRes, pg8::StaticOrder, true, true>(lds, g, S, E); }
        GRID_BAR();
    }
    { CArgsP ap = AP(); unsigned char* ws = ap->ws; int t2 = threadIdx.x; asm volatile("" : "+v"(t2));
      final_phase(WSB(WS_HB), (const float*)(ws + WS_SS), ap->final_g, ap->out, vcu * 8 + __builtin_amdgcn_readfirstlane(t2 >> 6), G * 8, t2 & 63); }
}

extern "C" void kernel_launch(void* const* d_in, const int* in_sizes, int n_in, void* d_out, int out_size, void* d_ws, size_t ws_size, hipStream_t stream) {
    static int grid = 0;
    if (grid == 0) {
        int dev = 0, cus = 0, per = 0;
        if (n_in != 18 || out_size != MF * DM || ws_size < WS_END) { fprintf(stderr, "kernel_launch: unexpected shapes (n_in %d out %d ws %zu)\n", n_in, out_size, ws_size); grid = -1; return; }
        (void)hipGetDevice(&dev); (void)hipDeviceGetAttribute(&cus, hipDeviceAttributeMultiprocessorCount, dev);
        (void)hipFuncSetAttribute((const void*)yoco_fwd, hipFuncAttributeMaxDynamicSharedMemorySize, LDS_BYTES);
        (void)hipOccupancyMaxActiveBlocksPerMultiprocessor(&per, (const void*)yoco_fwd, 512, LDS_BYTES);
        if (per < 1) per = 1;
        grid = cus * per;
        fprintf(stderr, "kernel_launch: grid %d (cus %d x %d)\n", grid, cus, per);
    }
    if (grid < 0) return;
    Args a{};
    const float** ap = (const float**)&a;
    for (int i = 0; i < 18; ++i) ap[i] = (const float*)d_in[i];
    a.out = (float*)d_out; a.ws = (unsigned char*)d_ws;
    void* args[] = {&a};
    hipError_t e = hipLaunchCooperativeKernel((const void*)yoco_fwd, dim3(grid), dim3(512), args, LDS_BYTES, stream);
    if (e != hipSuccess) fprintf(stderr, "cooperative launch failed: %s (grid %d)\n", hipGetErrorString(e), grid);
}
```

```cpp
#include <hip/hip_runtime.h>
#include <hip/hip_cooperative_groups.h>
#include <cstdio>
#include <cstdint>
namespace cg = cooperative_groups;
#define ATT_VCU vcu
namespace pg8 {
#define PG8_LAS __attribute__((address_space(3)))
typedef unsigned short bf16_t;
typedef short bf16x8 __attribute__((ext_vector_type(8)));
typedef float f32x4 __attribute__((ext_vector_type(4)));
typedef unsigned u32x4 __attribute__((ext_vector_type(4)));
constexpr int BM = 256, BK = 64, HALF = 128, HTB = HALF * BK * 2  , STAGE_BYTES = 8 * HTB, NXCD = 8, WGM = 4;

__host__ __device__ __forceinline__ int lds_byte(int r, int c) { const int st = (r >> 4) * 2 + (c >> 5), rr = r & 15, cc = c & 31, ob = rr * 64 + cc * 2; return st * 1024 + (ob ^ (((ob >> 9) & 1) << 5)); }
__host__ __device__ __forceinline__ void stage_rc(int b, int& R, int& C) { const int st = b / 1024, sb = b % 1024, swz = sb ^ (((sb >> 9) & 1) << 5); R = (st >> 1) * 16 + swz / 64; C = (st & 1) * 32 + (swz % 64) / 2; }
__host__ __device__ __forceinline__ int perm32(int rho) { const int n = rho >> 4, i = rho & 15; return 8 * (i >> 2) + 4 * n + (i & 3); }

struct Unit { int pm, pn; };
struct Gemm { const bf16_t* A; const bf16_t* Bt; int M, N, K; };

struct StaticOrder {
    int nM, nN, nwg, G, c;
    __host__ __device__ void init(int M, int N, int G_, int c_) { nM = M / BM; nN = N / BM; nwg = nM * nN; G = G_; c = c_; }
    __host__ __device__ bool next(int i, Unit& u) const {
        const long L = (long)i * G + c; if (L >= nwg) return false;
        int wgid = (int)L; { const int q = nwg / NXCD, r = nwg % NXCD, xcd = wgid % NXCD, off = wgid / NXCD; wgid = (xcd < r ? xcd * (q + 1) : r * (q + 1) + (xcd - r) * q) + off; }
        const int nig = WGM * nN, gid = wgid / nig, fm = gid * WGM, gsz = (nM - fm) < WGM ? (nM - fm) : WGM;
        u.pm = fm + ((wgid % nig) % gsz); u.pn = (wgid % nig) / gsz; return true;
    }
    __device__ __forceinline__ void a_ready(const Unit&) const {}
    __device__ __forceinline__ void done(const Unit&) const {}
};

__device__ __forceinline__ unsigned cvt_pk_bf16(float lo, float hi) { unsigned r; asm volatile("v_cvt_pk_bf16_f32 %0, %1, %2" : "=v"(r) : "v"(lo), "v"(hi)); return r; }
typedef float f32x2 __attribute__((ext_vector_type(2)));
template <class Epi, class Sched, bool ALIGN_EPI = false, bool SP2 = false>
__device__ __forceinline__ void gemm_phase(PG8_LAS unsigned char* lds, const Gemm g, const Sched& S, const Epi& E) {
    int tid = threadIdx.x; asm volatile("" : "+v"(tid)); const int wid = __builtin_amdgcn_readfirstlane(tid >> 6), lane = tid & 63, wr = wid >> 2, wc = wid & 3, fr = lane & 15, fq = lane >> 4;
    const int K = g.K, nt = K / BK;
    unsigned voffA[2], voffB[2];
#pragma unroll
    for (int i = 0; i < 2; ++i) { int R, C; stage_rc(tid * 16 + i * 8192, R, C); const int Rb = Epi::PERM ? ((R & ~31) + perm32(R & 31)) : R;
        voffA[i] = (unsigned)(R * K + C) * 2u; voffB[i] = (unsigned)(Rb * K + C) * 2u; }
    const size_t kstep = (size_t)(BK * 2);
    const size_t hstep = (size_t)HALF * K * 2;
    const size_t tstep = 2 * hstep;
    const unsigned ldsw = (unsigned)wid * 1024u;
    const int aoff = lds_byte(wr * 64 + fr, fq * 8), boff = lds_byte(wc * 32 + fr, fq * 8);
#define PG8_SA(b, h) (((b) * 2 + (h)) * HTB)
#define PG8_SB(b, h) ((4 + (b) * 2 + (h)) * HTB)
#define PG8_STAGE(bufoff, gbase, voff) do { _Pragma("unroll") for (int _i = 0; _i < 2; ++_i) \
        __builtin_amdgcn_global_load_lds((const unsigned*)((const char*)(gbase) + (voff)[_i]), (PG8_LAS unsigned*)(lds + (bufoff) + ldsw + _i * 8192), 16, 0, 0); } while (0)
#define PG8_LDA(dst, b, h) do { _Pragma("unroll") for (int m = 0; m < 4; ++m) _Pragma("unroll") for (int k = 0; k < 2; ++k) dst[m][k] = *(const PG8_LAS bf16x8*)(lds + PG8_SA(b, h) + aoff + m * 2048 + k * 1024); } while (0)
#define PG8_LDB(dst, b, h) do { _Pragma("unroll") for (int n = 0; n < 2; ++n) _Pragma("unroll") for (int k = 0; k < 2; ++k) dst[n][k] = *(const PG8_LAS bf16x8*)(lds + PG8_SB(b, h) + boff + n * 2048 + k * 1024); } while (0)
#define PG8_MMA(ai, bj, At, Bt) do { __builtin_amdgcn_s_setprio(1); _Pragma("unroll") for (int m = 0; m < 4; ++m) _Pragma("unroll") for (int n = 0; n < 2; ++n) _Pragma("unroll") for (int k = 0; k < 2; ++k) \
        acc[ai][bj][m][n] = __builtin_amdgcn_mfma_f32_16x16x32_bf16(Bt[n][k], At[m][k], acc[ai][bj][m][n], 0, 0, 0); __builtin_amdgcn_s_setprio(0); } while (0)
#define PG8_WAIT_V(n) asm volatile("s_waitcnt vmcnt(" #n ")" ::: "memory")
#define PG8_WAIT_L(n) asm volatile("s_waitcnt lgkmcnt(" #n ")" ::: "memory")
#define PG8_BAR __builtin_amdgcn_s_barrier()
#define PG8_SCHED __builtin_amdgcn_sched_barrier(0)
    Unit cur, nxt; int ui = 0;
    if (!S.next(0, cur)) return;
    f32x4 acc[2][2][4][2];
#pragma unroll
    for (int a = 0; a < 2; ++a)
#pragma unroll
        for (int b = 0; b < 2; ++b)
#pragma unroll
            for (int m = 0; m < 4; ++m)
#pragma unroll
                for (int n = 0; n < 2; ++n) acc[a][b][m][n] = (f32x4){0.f, 0.f, 0.f, 0.f};
    bf16x8 At[4][2], B0[2][2], B1[2][2];
    const char* cA = (const char*)g.A + (size_t)cur.pm * tstep; const char* cB = (const char*)g.Bt + (size_t)cur.pn * tstep;
    S.a_ready(cur);
    if constexpr (SP2) {
        PG8_STAGE(PG8_SB(0, 0), cB, voffB); PG8_STAGE(PG8_SB(0, 1), cB + hstep, voffB); PG8_STAGE(PG8_SA(0, 0), cA, voffA); PG8_STAGE(PG8_SA(0, 1), cA + hstep, voffA);
        if (wr == 1) PG8_BAR;
        PG8_WAIT_V(2); PG8_BAR;
        PG8_STAGE(PG8_SB(1, 0), cB + kstep, voffB); PG8_STAGE(PG8_SA(1, 0), cA + kstep, voffA); PG8_STAGE(PG8_SB(1, 1), cB + hstep + kstep, voffB);
        PG8_WAIT_V(6); PG8_BAR;
    } else {
        PG8_STAGE(PG8_SB(0, 0), cB, voffB); PG8_STAGE(PG8_SA(0, 0), cA, voffA); PG8_STAGE(PG8_SB(0, 1), cB + hstep, voffB); PG8_STAGE(PG8_SA(0, 1), cA + hstep, voffA);
        if (wr == 1) PG8_BAR;
        PG8_WAIT_V(4); PG8_BAR;
        PG8_STAGE(PG8_SB(1, 0), cB + kstep, voffB); PG8_STAGE(PG8_SA(1, 0), cA + kstep, voffA); PG8_STAGE(PG8_SB(1, 1), cB + hstep + kstep, voffB);
        PG8_WAIT_V(6); PG8_BAR;
    }
    for (;;) {
        const bool has_next = S.next(ui + 1, nxt);
        const char* nA = has_next ? (const char*)g.A + (size_t)nxt.pm * tstep : cA; const char* nB = has_next ? (const char*)g.Bt + (size_t)nxt.pn * tstep : cB;
        for (int t = 0; t < nt; t += 2) {
            const bool last = (t == nt - 2);
            const char* a1 = cA + (size_t)(t + 1) * kstep;
            const char* a2 = last ? nA : cA + (size_t)(t + 2) * kstep; const char* b2 = last ? nB : cB + (size_t)(t + 2) * kstep;
            const char* a3 = a2 + kstep; const char* b3 = b2 + kstep;
            if (last && has_next) S.a_ready(nxt);
            if constexpr (SP2) {
            PG8_LDB(B0, 0, 0); PG8_LDB(B1, 0, 1); PG8_SCHED; PG8_LDA(At, 0, 0); PG8_STAGE(PG8_SA(1, 1), a1 + hstep, voffA);
            PG8_WAIT_V(8); PG8_WAIT_L(0); PG8_BAR; PG8_MMA(0, 0, At, B0); PG8_MMA(0, 1, At, B1); PG8_BAR; PG8_SCHED;
            PG8_LDA(At, 0, 1); PG8_STAGE(PG8_SB(0, 0), b2, voffB); PG8_STAGE(PG8_SB(0, 1), b2 + hstep, voffB); PG8_STAGE(PG8_SA(0, 0), a2, voffA);
            PG8_WAIT_V(8); PG8_WAIT_L(0); PG8_BAR; PG8_MMA(1, 0, At, B0); PG8_MMA(1, 1, At, B1); PG8_BAR; PG8_SCHED;
            PG8_LDB(B0, 1, 0); PG8_LDB(B1, 1, 1); PG8_SCHED; PG8_LDA(At, 1, 0); PG8_STAGE(PG8_SA(0, 1), a2 + hstep, voffA);
            PG8_WAIT_V(8); PG8_WAIT_L(0); PG8_BAR; PG8_MMA(0, 0, At, B0); PG8_MMA(0, 1, At, B1); PG8_BAR; PG8_SCHED;
            PG8_LDA(At, 1, 1); PG8_STAGE(PG8_SB(1, 0), b3, voffB); PG8_STAGE(PG8_SB(1, 1), b3 + hstep, voffB); PG8_STAGE(PG8_SA(1, 0), a3, voffA);
            PG8_WAIT_V(8); PG8_WAIT_L(0); PG8_BAR; PG8_MMA(1, 0, At, B0); PG8_MMA(1, 1, At, B1); PG8_BAR; PG8_SCHED;
            } else {
            PG8_LDB(B0, 0, 0); PG8_SCHED; PG8_LDA(At, 0, 0); PG8_STAGE(PG8_SA(1, 1), a1 + hstep, voffA);
            PG8_WAIT_L(8); PG8_BAR; PG8_WAIT_L(0); PG8_MMA(0, 0, At, B0); PG8_BAR; PG8_SCHED;
            PG8_LDB(B1, 0, 1); PG8_STAGE(PG8_SB(0, 0), b2, voffB);
            PG8_BAR; PG8_WAIT_L(0); PG8_MMA(0, 1, At, B1); PG8_BAR;
            PG8_LDA(At, 0, 1); PG8_STAGE(PG8_SA(0, 0), a2, voffA);
            PG8_BAR; PG8_WAIT_L(0); PG8_MMA(1, 0, At, B0); PG8_BAR; PG8_SCHED;
            PG8_STAGE(PG8_SB(0, 1), b2 + hstep, voffB);
            PG8_WAIT_V(6); PG8_BAR; PG8_MMA(1, 1, At, B1); PG8_BAR;
            PG8_LDB(B0, 1, 0); PG8_SCHED; PG8_LDA(At, 1, 0); PG8_STAGE(PG8_SA(0, 1), a2 + hstep, voffA);
            PG8_WAIT_L(8); PG8_BAR; PG8_WAIT_L(0); PG8_MMA(0, 0, At, B0); PG8_BAR; PG8_SCHED;
            PG8_LDB(B1, 1, 1); PG8_STAGE(PG8_SB(1, 0), b3, voffB);
            PG8_BAR; PG8_WAIT_L(0); PG8_MMA(0, 1, At, B1); PG8_BAR;
            PG8_LDA(At, 1, 1); PG8_STAGE(PG8_SA(1, 0), a3, voffA);
            PG8_BAR; PG8_WAIT_L(0); PG8_MMA(1, 0, At, B0); PG8_BAR; PG8_SCHED;
            PG8_STAGE(PG8_SB(1, 1), b3 + hstep, voffB);
            PG8_WAIT_V(6); PG8_BAR; PG8_MMA(1, 1, At, B1); PG8_BAR;
            }
        }
        if constexpr (ALIGN_EPI) { if (wr == 0) PG8_BAR; }
        if constexpr (!Epi::AFTER_DRAIN) { E(acc, cur, wr, wc, fr, fq); S.done(cur); }
        if (!has_next) break;
#pragma unroll
        for (int a = 0; a < 2; ++a)
#pragma unroll
            for (int b = 0; b < 2; ++b)
#pragma unroll
                for (int m = 0; m < 4; ++m)
#pragma unroll
                    for (int n = 0; n < 2; ++n) acc[a][b][m][n] = (f32x4){0.f, 0.f, 0.f, 0.f};
        cur = nxt; cA = nA; cB = nB; ++ui;
        if constexpr (ALIGN_EPI) { if (wr == 1) PG8_BAR; }
    }
    PG8_WAIT_V(0);
    if constexpr (!ALIGN_EPI) { if (wr == 0) PG8_BAR; }
    PG8_BAR;
    if constexpr (Epi::AFTER_DRAIN) { E.fused(acc, cur, wr, wc, fr, fq, lds, wid, lane); S.done(cur); }
#undef PG8_SA
#undef PG8_SB
#undef PG8_STAGE
#undef PG8_LDA
#undef PG8_LDB
#undef PG8_MMA
#undef PG8_WAIT_V
#undef PG8_WAIT_L
#undef PG8_BAR
#undef PG8_SCHED
}
}
#define LAS __attribute__((address_space(3)))
typedef unsigned short bf16_t;
typedef short bf16x8 __attribute__((ext_vector_type(8)));
typedef float f32x4 __attribute__((ext_vector_type(4)));
typedef float f32x16 __attribute__((ext_vector_type(16)));
typedef unsigned u32x4 __attribute__((ext_vector_type(4)));
typedef unsigned u32x2 __attribute__((ext_vector_type(2)));
constexpr int DM = 1024, NBATCH = 16, SEQ = 2048, MF = NBATCH * SEQ;
constexpr int HM = MF;
constexpr int KM = MF;
constexpr int VP = MF + 64;
constexpr size_t BUF_ELEMS = (size_t)33792 * 1024;
constexpr int PADR = 48, NMETA = 16;
constexpr float EPS = 1e-6f;
constexpr float QSCALE = 0.125f * 1.4426950408889634f;
constexpr size_t MiB = 1u << 20;
constexpr size_t WS_WAIN = 0, WS_WAOUT = 16 * MiB, WS_WKQZ = 20 * MiB, WS_WVT = 26 * MiB, WS_WQZ1 = 28 * MiB, WS_WBOUT = 32 * MiB, WS_SS = 36 * MiB, WS_CTL = 39 * MiB,
                 WS_HB = 40 * MiB, WS_BUF0 = 106 * MiB, WS_BUF1 = 172 * MiB, WS_BUF2 = 238 * MiB, WS_BUF3 = 304 * MiB, WS_BUF4 = 370 * MiB, WS_END = 436 * MiB;
constexpr int LDS_BYTES = 135168;

using pg8::cvt_pk_bf16;
__device__ __forceinline__ float bf_lo(unsigned w) { return __uint_as_float(w << 16); }
__device__ __forceinline__ float bf_hi(unsigned w) { return __uint_as_float(w & 0xffff0000u); }
__device__ __forceinline__ float fast_exp2(float x) { return __builtin_amdgcn_exp2f(x); }
__device__ __forceinline__ float silu_f(float z) { return z * __builtin_amdgcn_rcpf(1.0f + fast_exp2(-1.4426950408889634f * z)); }
__device__ __forceinline__ float wave_sum(float v) {
#pragma unroll
    for (int o = 1; o < 64; o <<= 1) v += __shfl_xor(v, o);
    return v;
}
__device__ __forceinline__ float row_rstd(const float* part, int row, int fq) {
    const f32x4 p = *(const f32x4*)(part + (size_t)row * 16 + 4 * fq);
    float s = (p[0] + p[1]) + (p[2] + p[3]);
    s += __shfl_xor(s, 16); s += __shfl_xor(s, 32);
    return rsqrtf(s * (1.0f / DM) + EPS);
}

__device__ __forceinline__ f32x4 rstd_load(const float* part, int row, int fq) { return *(const f32x4*)(part + (size_t)row * 16 + 4 * fq); }
__device__ __forceinline__ float rstd_reduce(const f32x4 p) {
    float s = (p[0] + p[1]) + (p[2] + p[3]);
    s += __shfl_xor(s, 16); s += __shfl_xor(s, 32);
    return rsqrtf(s * (1.0f / DM) + EPS);
}
__device__ __forceinline__ float dpp_ror1(float x) { return __int_as_float(__builtin_amdgcn_update_dpp(0, __float_as_int(x), 0x121, 0xF, 0xF, false)); }
__device__ __forceinline__ float dpp_ror2(float x) { return __int_as_float(__builtin_amdgcn_update_dpp(0, __float_as_int(x), 0x122, 0xF, 0xF, false)); }
__device__ __forceinline__ float dpp_shr1(float old, float x) { return __int_as_float(__builtin_amdgcn_update_dpp(__float_as_int(old), __float_as_int(x), 0x111, 0xF, 0xF, false)); }
__device__ __forceinline__ float dpp_shr2(float old, float x) { return __int_as_float(__builtin_amdgcn_update_dpp(__float_as_int(old), __float_as_int(x), 0x112, 0xF, 0xF, false)); }
struct EpiAIn {
    static constexpr bool PERM = false, AFTER_DRAIN = false;
    const float* part; bf16_t* vbuf; bf16_t* gzbuf; bf16_t* ybuf; const float* cw; const float* cb;
    __device__ __forceinline__ void operator()(const f32x4 (&acc)[2][2][4][2], const pg8::Unit& u, int wr, int wc, int fr, int fq) const {
        const int ch0 = 64 * u.pn + 16 * wc + 4 * fq;
        const f32x4 w0 = *(const f32x4*)(cw + ch0), w1 = *(const f32x4*)(cw + DM + ch0), w2 = *(const f32x4*)(cw + 2 * DM + ch0), bb = *(const f32x4*)(cb + ch0);
        f32x4 pp[2][4];
#pragma unroll
        for (int ai = 0; ai < 2; ++ai)
#pragma unroll
            for (int m = 0; m < 4; ++m) pp[ai][m] = rstd_load(part, u.pm * 256 + ai * 128 + wr * 64 + m * 16 + fr, fq);
#pragma unroll
        for (int ai = 0; ai < 2; ++ai) {
            f32x4 vprev = (f32x4){0.f, 0.f, 0.f, 0.f};
#pragma unroll
            for (int m = 0; m < 4; ++m) {
                const int row = u.pm * 256 + ai * 128 + wr * 64 + m * 16 + fr;
                const float rs = rstd_reduce(pp[ai][m]);
                const f32x4 b = acc[ai][0][m][0] * rs, c = acc[ai][0][m][1] * rs, hin = acc[ai][1][m][0] * rs, z = acc[ai][1][m][1] * rs;
                const f32x4 v = c * hin;
                f32x4 gz, y;
#pragma unroll
                for (int j = 0; j < 4; ++j) {
                    gz[j] = b[j] * silu_f(z[j]);
                    const float p1 = dpp_shr1(dpp_ror1(vprev[j]), v[j]), p2 = dpp_shr2(dpp_ror2(vprev[j]), v[j]);
                    y[j] = gz[j] * (w0[j] * p2 + w1[j] * p1 + w2[j] * v[j] + bb[j]);
                }
                const size_t o = (size_t)row * DM + ch0;
                if (m == 0 && fr < 2) {
                    u32x2 wv, wg; wv.x = cvt_pk_bf16(v[0], v[1]); wv.y = cvt_pk_bf16(v[2], v[3]); wg.x = cvt_pk_bf16(gz[0], gz[1]); wg.y = cvt_pk_bf16(gz[2], gz[3]);
                    *(u32x2*)(vbuf + o) = wv; *(u32x2*)(gzbuf + o) = wg;
                } else {
                    u32x2 wy; wy.x = cvt_pk_bf16(y[0], y[1]); wy.y = cvt_pk_bf16(y[2], y[3]);
                    *(u32x2*)(ybuf + o) = wy;
                    if (m == 3 && fr >= 14) { u32x2 wv; wv.x = cvt_pk_bf16(v[0], v[1]); wv.y = cvt_pk_bf16(v[2], v[3]); *(u32x2*)(vbuf + o) = wv; }
                }
                vprev = v;
            }
        }
    }
};
struct EpiRes {
    static constexpr bool PERM = true, AFTER_DRAIN = false;
    bf16_t* hb; float* part;
    __device__ __forceinline__ void operator()(const f32x4 (&acc)[2][2][4][2], const pg8::Unit& u, int wr, int wc, int fr, int fq) const {
        u32x4 old[2][4][2];
#pragma unroll
        for (int ai = 0; ai < 2; ++ai)
#pragma unroll
            for (int m = 0; m < 4; ++m)
#pragma unroll
                for (int bj = 0; bj < 2; ++bj)
                    old[ai][m][bj] = *(const u32x4*)(hb + (size_t)(u.pm * 256 + ai * 128 + wr * 64 + m * 16 + fr) * DM + u.pn * 256 + bj * 128 + wc * 32 + 8 * fq);
#pragma unroll
        for (int ai = 0; ai < 2; ++ai)
#pragma unroll
            for (int m = 0; m < 4; ++m) {
                const int row = u.pm * 256 + ai * 128 + wr * 64 + m * 16 + fr;
                float ssq = 0.f;
#pragma unroll
                for (int bj = 0; bj < 2; ++bj) {
                    bf16_t* p = hb + (size_t)row * DM + u.pn * 256 + bj * 128 + wc * 32 + 8 * fq;
                    const u32x4 o4 = old[ai][m][bj];
                    const f32x4 a0 = acc[ai][bj][m][0], a1 = acc[ai][bj][m][1];
                    float v[8];
                    v[0] = bf_lo(o4.x) + a0[0]; v[1] = bf_hi(o4.x) + a0[1]; v[2] = bf_lo(o4.y) + a0[2]; v[3] = bf_hi(o4.y) + a0[3];
                    v[4] = bf_lo(o4.z) + a1[0]; v[5] = bf_hi(o4.z) + a1[1]; v[6] = bf_lo(o4.w) + a1[2]; v[7] = bf_hi(o4.w) + a1[3];
#pragma unroll
                    for (int i = 0; i < 8; ++i) ssq += v[i] * v[i];
                    u32x4 w; w.x = cvt_pk_bf16(v[0], v[1]); w.y = cvt_pk_bf16(v[2], v[3]); w.z = cvt_pk_bf16(v[4], v[5]); w.w = cvt_pk_bf16(v[6], v[7]);
                    *(u32x4*)p = w;
                }
                ssq += __shfl_xor(ssq, 16); ssq += __shfl_xor(ssq, 32);
                if (fq == 0) part[(size_t)row * 16 + 4 * u.pn + wc] = ssq;
            }
    }
};
struct EpiKQZ {
    static constexpr bool PERM = true, AFTER_DRAIN = false;
    const float* part; bf16_t* kqz; int tbase;
    __device__ __forceinline__ void operator()(const f32x4 (&acc)[2][2][4][2], const pg8::Unit& u, int wr, int wc, int fr, int fq) const {
        const int t = (u.pn >> 2) + tbase;
        bf16_t* dst = kqz + (size_t)t * BUF_ELEMS;
        const float sc = (t == 1) ? QSCALE : 1.0f;
        const int col0 = (u.pn & 3) * 256 + wc * 32 + 8 * fq;
        f32x4 pp[2][4];
#pragma unroll
        for (int ai = 0; ai < 2; ++ai)
#pragma unroll
            for (int m = 0; m < 4; ++m) pp[ai][m] = rstd_load(part, u.pm * 256 + ai * 128 + wr * 64 + m * 16 + fr, fq);
#pragma unroll
        for (int ai = 0; ai < 2; ++ai)
#pragma unroll
            for (int m = 0; m < 4; ++m) {
                const int row = u.pm * 256 + ai * 128 + wr * 64 + m * 16 + fr;
                const float rs = rstd_reduce(pp[ai][m]) * sc;
#pragma unroll
                for (int bj = 0; bj < 2; ++bj) {
                    f32x4 a0 = acc[ai][bj][m][0] * rs, a1 = acc[ai][bj][m][1] * rs;
                    if (t == 2) {
#pragma unroll
                        for (int j = 0; j < 4; ++j) { a0[j] = silu_f(a0[j]); a1[j] = silu_f(a1[j]); }
                    }
                    u32x4 w; w.x = cvt_pk_bf16(a0[0], a0[1]); w.y = cvt_pk_bf16(a0[2], a0[3]); w.z = cvt_pk_bf16(a1[0], a1[1]); w.w = cvt_pk_bf16(a1[2], a1[3]);
                    *(u32x4*)(dst + (size_t)row * DM + col0 + bj * 128) = w;
                }
            }
    }
};
struct EpiVt {
    static constexpr bool PERM = true, AFTER_DRAIN = false;
    const float* part; bf16_t* vt;
    __device__ __forceinline__ void operator()(const f32x4 (&acc)[2][2][4][2], const pg8::Unit& u, int wr, int wc, int fr, int fq) const {
        const int lane = fr + 16 * fq;
        float rsl;
        { const int tok = u.pn * 256 + 128 * (lane >> 5) + 32 * wc + (lane & 31);
          const f32x4* p = (const f32x4*)(part + (size_t)tok * 16);
          const f32x4 p0 = p[0], p1 = p[1], p2 = p[2], p3 = p[3];
          const float s = ((p0[0] + p0[1]) + (p0[2] + p0[3])) + ((p1[0] + p1[1]) + (p1[2] + p1[3])) + ((p2[0] + p2[1]) + (p2[2] + p2[3])) + ((p3[0] + p3[1]) + (p3[2] + p3[3]));
          rsl = rsqrtf(s * (1.0f / DM) + EPS); }
        float rs[2][8];
#pragma unroll
        for (int bj = 0; bj < 2; ++bj)
#pragma unroll
            for (int i = 0; i < 8; ++i) rs[bj][i] = __shfl(rsl, 32 * bj + 8 * fq + i);
#pragma unroll
        for (int ai = 0; ai < 2; ++ai)
#pragma unroll
            for (int m = 0; m < 4; ++m) {
                const int e = u.pm * 256 + ai * 128 + wr * 64 + m * 16 + fr;
#pragma unroll
                for (int bj = 0; bj < 2; ++bj)
#pragma unroll
                    for (int n = 0; n < 2; ++n) {
                        const f32x4 a = acc[ai][bj][m][n];
                        u32x2 w; w.x = cvt_pk_bf16(a[0] * rs[bj][4 * n + 0], a[1] * rs[bj][4 * n + 1]); w.y = cvt_pk_bf16(a[2] * rs[bj][4 * n + 2], a[3] * rs[bj][4 * n + 3]);
                        *(u32x2*)(vt + (size_t)e * VP + u.pn * 256 + bj * 128 + wc * 32 + 16 * (fq >> 1) + 8 * n + 4 * (fq & 1)) = w;
                    }
            }
    }
};

__device__ __forceinline__ void mini_gemm4(const bf16_t* __restrict__ A, const bf16_t* __restrict__ w0, const bf16_t* __restrict__ w1, const bf16_t* __restrict__ w2, const bf16_t* __restrict__ w3, f32x4 (&acc)[4], int wave, int lane, LAS unsigned char* lds) {
    const int off = (lane & 15) * DM + (lane >> 4) * 8 + wave * 128;
    const bf16_t* ap = A + off; const bf16_t* p0 = w0 + off; const bf16_t* p1 = w1 + off; const bf16_t* p2 = w2 + off; const bf16_t* p3 = w3 + off;
    bf16x8 bv[4], a0[4], a1[4], a2[4], a3[4];
#pragma unroll
    for (int kk = 0; kk < 4; ++kk) { bv[kk] = *(const bf16x8*)(ap + kk * 32); a0[kk] = *(const bf16x8*)(p0 + kk * 32); a1[kk] = *(const bf16x8*)(p1 + kk * 32); a2[kk] = *(const bf16x8*)(p2 + kk * 32); a3[kk] = *(const bf16x8*)(p3 + kk * 32); }
#pragma unroll
    for (int i = 0; i < 4; ++i) acc[i] = (f32x4){0.f, 0.f, 0.f, 0.f};
#pragma unroll
    for (int kk = 0; kk < 4; ++kk) {
        acc[0] = __builtin_amdgcn_mfma_f32_16x16x32_bf16(a0[kk], bv[kk], acc[0], 0, 0, 0); acc[1] = __builtin_amdgcn_mfma_f32_16x16x32_bf16(a1[kk], bv[kk], acc[1], 0, 0, 0);
        acc[2] = __builtin_amdgcn_mfma_f32_16x16x32_bf16(a2[kk], bv[kk], acc[2], 0, 0, 0); acc[3] = __builtin_amdgcn_mfma_f32_16x16x32_bf16(a3[kk], bv[kk], acc[3], 0, 0, 0);
    }
    LAS f32x4* red = (LAS f32x4*)lds;
#pragma unroll
    for (int i = 0; i < 4; ++i) red[(wave * 4 + i) * 64 + lane] = acc[i];
    __syncthreads();
    if (wave == 0) {
#pragma unroll
        for (int w = 1; w < 8; ++w)
#pragma unroll
            for (int i = 0; i < 4; ++i) acc[i] += red[(w * 4 + i) * 64 + lane];
    }
    __syncthreads();
}
__device__ __forceinline__ float meta_rstd(const float* part, int m) {
    const f32x4* p = (const f32x4*)(part + (size_t)(HM + m) * 16);
    const f32x4 p0 = p[0], p1 = p[1], p2 = p[2], p3 = p[3];
    const float s = ((p0[0] + p0[1]) + (p0[2] + p0[3])) + ((p1[0] + p1[1]) + (p1[2] + p1[3])) + ((p2[0] + p2[1]) + (p2[2] + p2[3])) + ((p3[0] + p3[1]) + (p3[2] + p3[3]));
    return rsqrtf(s * (1.0f / DM) + EPS);
}
__device__ __forceinline__ void meta_ain_job(int j, const bf16_t* hb, const bf16_t* W, const float* part, bf16_t* vbuf, bf16_t* gzbuf, int wave, int lane, LAS unsigned char* lds) {
    const int pn = j >> 2, wc = j & 3, fr = lane & 15, fq = lane >> 4;
    const bf16_t* wb = W + (size_t)(256 * pn + 32 * wc) * DM;
    f32x4 acc[4];
    mini_gemm4(hb + (size_t)HM * DM, wb, wb + 16 * DM, wb + 128 * DM, wb + 144 * DM, acc, wave, lane, lds);
    if (wave != 0) return;
    const float rs = meta_rstd(part, fr);
    const f32x4 bb = acc[0] * rs, c = acc[1] * rs, hin = acc[2] * rs, z = acc[3] * rs;
    const f32x4 v = c * hin; f32x4 gz;
#pragma unroll
    for (int q = 0; q < 4; ++q) gz[q] = bb[q] * silu_f(z[q]);
    u32x2 wv, wg; wv.x = cvt_pk_bf16(v[0], v[1]); wv.y = cvt_pk_bf16(v[2], v[3]); wg.x = cvt_pk_bf16(gz[0], gz[1]); wg.y = cvt_pk_bf16(gz[2], gz[3]);
    const size_t o = (size_t)(HM + fr) * DM + 64 * pn + 16 * wc + 4 * fq;
    *(u32x2*)(vbuf + o) = wv; *(u32x2*)(gzbuf + o) = wg;
}
__device__ __forceinline__ void meta_res_job(int j, const bf16_t* A, const bf16_t* W, bf16_t* hb, float* part, int wave, int lane, LAS unsigned char* lds) {
    const int fr = lane & 15, fq = lane >> 4;
    const bf16_t* wb = W + (size_t)(64 * j) * DM;
    f32x4 acc[4];
    mini_gemm4(A + (size_t)HM * DM, wb, wb + 16 * DM, wb + 32 * DM, wb + 48 * DM, acc, wave, lane, lds);
    if (wave != 0) return;
    float ssq = 0.f;
#pragma unroll
    for (int i = 0; i < 4; ++i) {
        bf16_t* p = hb + (size_t)(HM + fr) * DM + 64 * j + 16 * i + 4 * fq;
        const u32x2 old = *(const u32x2*)p;
        const float v0 = bf_lo(old.x) + acc[i][0], v1 = bf_hi(old.x) + acc[i][1], v2 = bf_lo(old.y) + acc[i][2], v3 = bf_hi(old.y) + acc[i][3];
        ssq += (v0 * v0 + v1 * v1) + (v2 * v2 + v3 * v3);
        u32x2 w; w.x = cvt_pk_bf16(v0, v1); w.y = cvt_pk_bf16(v2, v3); *(u32x2*)p = w;
    }
    ssq += __shfl_xor(ssq, 16); ssq += __shfl_xor(ssq, 32);
    if (fq == 0) part[(size_t)(HM + fr) * 16 + j] = ssq;
}
__device__ __forceinline__ void meta_k_job(int j, const bf16_t* hb, const bf16_t* W, const float* part, bf16_t* kb, int wave, int lane, LAS unsigned char* lds) {
    const int fr = lane & 15, fq = lane >> 4;
    const bf16_t* wb = W + (size_t)(64 * j) * DM;
    f32x4 acc[4];
    mini_gemm4(hb + (size_t)HM * DM, wb, wb + 16 * DM, wb + 32 * DM, wb + 48 * DM, acc, wave, lane, lds);
    if (wave != 0) return;
    const float rs = meta_rstd(part, fr);
#pragma unroll
    for (int i = 0; i < 4; ++i) { const f32x4 a = acc[i] * rs; u32x2 w; w.x = cvt_pk_bf16(a[0], a[1]); w.y = cvt_pk_bf16(a[2], a[3]);
        *(u32x2*)(kb + (size_t)(KM + PADR + fr) * DM + 64 * j + 16 * i + 4 * fq) = w; }
}
__device__ __forceinline__ void meta_v_job(int j, const bf16_t* hb, const bf16_t* Wv, const float* part, bf16_t* vt, int wave, int lane, LAS unsigned char* lds) {
    const int fr = lane & 15, fq = lane >> 4;
    const bf16_t* wb = Wv + (size_t)(64 * j) * DM;
    f32x4 acc[4];
    mini_gemm4(hb + (size_t)HM * DM, wb, wb + 16 * DM, wb + 32 * DM, wb + 48 * DM, acc, wave, lane, lds);
    if (wave != 0) return;
    const float rs = meta_rstd(part, fr);
    const int pos = 8 * ((fr >> 2) & 1) + 4 * (fr >> 3) + (fr & 3);
#pragma unroll
    for (int i = 0; i < 4; ++i)
#pragma unroll
        for (int r = 0; r < 4; ++r) { const int e = 64 * j + 16 * i + 4 * fq + r; vt[(size_t)e * VP + MF + PADR + pos] = (bf16_t)(cvt_pk_bf16(acc[i][r] * rs, 0.f) & 0xffffu); }
}
#define XB_TMO      128
#define XB_XCNT(j)  (256  + 64 * (j))
#define XB_XSUB(j)  (1280 + 64 * (j))
#define XB_XGEN(j)  (2304 + 64 * (j))
#define XB_TOP      3328
#define XB_TOPGEN   3392
#define XCD_BAR_WORDS 3456
#define XB_SPIN_CAP (1u << 18)

__device__ __forceinline__ unsigned xb_ld(unsigned* p)              { return __hip_atomic_load(p, __ATOMIC_RELAXED, __HIP_MEMORY_SCOPE_AGENT); }
__device__ __forceinline__ unsigned xb_add(unsigned* p, unsigned v) { return __hip_atomic_fetch_add(p, v, __ATOMIC_RELAXED, __HIP_MEMORY_SCOPE_AGENT); }
__device__ __forceinline__ unsigned xb_xcc_id() { return (unsigned)__builtin_amdgcn_s_getreg((3 << 11) | 20) & 0xFu; }
#define XB_SPIN(cond, bar) do { unsigned _sp = 0; while (cond) { __builtin_amdgcn_s_sleep(1); \
    if ((++_sp & 255u) == 0u) { if (xb_ld(&(bar)[XB_TMO])) break; if (_sp > XB_SPIN_CAP) { atomicAdd(&(bar)[XB_TMO], 1u); break; } } } } while (0)

struct XcdBarrier {
    unsigned* bar; unsigned x;
    volatile LAS unsigned* st;
};

__device__ __forceinline__ XcdBarrier xcd_barrier_post(unsigned* bar, volatile LAS unsigned* st) {
    XcdBarrier b; b.bar = bar; b.x = xb_xcc_id(); b.st = st;
    if (threadIdx.x == 0) (void)xb_add(&bar[XB_XCNT(b.x)], 1u);
    return b;
}
__device__ __forceinline__ void xcd_barrier_complete(unsigned* bar, unsigned x, unsigned& nloc, unsigned& nx) {
    const unsigned G = gridDim.x * gridDim.y * gridDim.z;
    unsigned sum, cnt, mine, sp = 0u;
    for (;;) {
        sum = 0u; cnt = 0u; mine = 0u;
#pragma unroll
        for (unsigned j = 0; j < 16; ++j) { const unsigned c = xb_ld(&bar[XB_XCNT(j)]); sum += c; cnt += (c > 0u) ? 1u : 0u; mine = (j == x) ? c : mine; }
        if (sum == G) break;
        __builtin_amdgcn_s_sleep(1);
        if ((++sp & 255u) == 0u) { if (xb_ld(&bar[XB_TMO])) break; if (sp > XB_SPIN_CAP) { atomicAdd(&bar[XB_TMO], 1u); break; } }
    }
    nloc = mine > 0u ? mine : 1u; nx = cnt > 0u ? cnt : 1u;
}

__device__ __forceinline__ void xcd_barrier(const XcdBarrier& b) {
    asm volatile("s_waitcnt vmcnt(0)" ::: "memory");
    __syncthreads();
    if (threadIdx.x == 0) {
        unsigned* bar = b.bar;
        __builtin_amdgcn_s_waitcnt(0);
        unsigned nloc = b.st[0], nx = b.st[1];
        if (nloc == 0u) { xcd_barrier_complete(bar, b.x, nloc, nx); b.st[0] = nloc; b.st[1] = nx; }
        const unsigned old = xb_add(&bar[XB_XSUB(b.x)], 1u);
        const unsigned gen = old / nloc;
        if (old + 1u == (gen + 1u) * nloc) {
            __builtin_amdgcn_fence(__ATOMIC_RELEASE, "agent");
            asm volatile("s_waitcnt vmcnt(0)" ::: "memory");
            const unsigned og = xb_add(&bar[XB_TOP], 1u);
            const unsigned tg = og / nx;
            if (og + 1u == (tg + 1u) * nx) xb_add(&bar[XB_TOPGEN], 1u);
            else XB_SPIN(xb_ld(&bar[XB_TOPGEN]) == tg, bar);
            __builtin_amdgcn_fence(__ATOMIC_ACQUIRE, "agent");
            xb_add(&bar[XB_XGEN(b.x)], 1u);
            asm volatile("s_waitcnt vmcnt(0)" ::: "memory");
        } else {
            XB_SPIN(xb_ld(&bar[XB_XGEN(b.x)]) == gen, bar);
            __builtin_amdgcn_fence(__ATOMIC_ACQUIRE, "agent");
            asm volatile("s_waitcnt vmcnt(0)" ::: "memory");
        }
    }
    __syncthreads();
}
__device__ __forceinline__ int crow(int r, int hi) { return (r & 3) + 8 * (r >> 2) + 4 * hi; }
#define ATT_BAR() asm volatile("s_waitcnt lgkmcnt(0)\n\ts_barrier" ::: "memory")
__device__ __forceinline__ void att_wait_vm(int n) {
    if (n >= 8) asm volatile("s_waitcnt vmcnt(8)" ::: "memory"); else if (n == 6) asm volatile("s_waitcnt vmcnt(6)" ::: "memory");
    else if (n == 4) asm volatile("s_waitcnt vmcnt(4)" ::: "memory"); else if (n == 2) asm volatile("s_waitcnt vmcnt(2)" ::: "memory"); else asm volatile("s_waitcnt vmcnt(0)" ::: "memory");
}
constexpr float ATT_THR = 12.0f;
constexpr int ATT_VRING = 65536, ATT_XSTRIDE = 17408;
__device__ __forceinline__ void attn_unit(LAS unsigned char* lds, const bf16_t* Qb, const bf16_t* __restrict__ Kb, const bf16_t* __restrict__ Vt, const bf16_t* __restrict__ Zs,
                                          bf16_t* Ob  , const float* __restrict__ subg, float lam, float oml, int b, int h, int j) {
    int tid = threadIdx.x; asm volatile("" : "+v"(tid));
    const int lane = tid & 63, wid = __builtin_amdgcn_readfirstlane(tid >> 6), sub = wid & 3, map = wid >> 2, r32 = lane & 31, hi = lane >> 5;
    const size_t rowbase = (size_t)b * SEQ, qbase = rowbase + 128 * j;
    const int NT = 2 * j + 3, tmax = 2 * j + 1 + (sub >> 1);
    const bool active = true;
    bf16x8 qf[4];
    { const bf16_t* qsrc = Qb + (qbase + 32 * sub + r32) * DM + h * 128 + map * 64 + hi * 8;
#pragma unroll
      for (int ks = 0; ks < 4; ++ks) qf[ks] = __builtin_nontemporal_load((const bf16x8*)(qsrc + 16 * ks)); }
    const int prow = lane >> 3, pc = lane & 7;
    const int krow = 8 * wid + prow;
    const unsigned koff = (unsigned)(krow * DM + ((pc ^ ((krow >> 1) & 7)) << 3)) * 2u;
    const int vrow0 = 16 * wid + prow, vrow1 = vrow0 + 8;
    const unsigned voff0 = (unsigned)(vrow0 * VP + ((pc ^ ((vrow0 >> 1) & 7)) << 3)) * 2u, voff1 = (unsigned)(vrow1 * VP + ((pc ^ ((vrow1 >> 1) & 7)) << 3)) * 2u;
    const char* kbase = (const char*)(Kb + h * 128);
    const char* vbase = (const char*)(Vt + (size_t)(h * 128) * VP);
#define DMA16(g, off) __builtin_amdgcn_global_load_lds((const unsigned*)(g), (LAS unsigned*)(lds + (off)), 16, 0, 0)
#define TILE_ROW0(t) ((t) == 0 ? (size_t)KM : rowbase + (size_t)((t) - 1) * 64)
#define DMA_K(t, slot) do { const char* kb_ = kbase + TILE_ROW0(t) * (DM * 2); DMA16(kb_ + koff, (slot) * 16384 + wid * 1024); DMA16(kb_ + 128 + koff, (slot) * 16384 + 8192 + wid * 1024); } while (0)
#define DMA_V(t, slot) do { const char* vb_ = vbase + TILE_ROW0(t) * 2; DMA16(vb_ + voff0, ATT_VRING + (slot) * 16384 + wid * 2048); DMA16(vb_ + voff1, ATT_VRING + (slot) * 16384 + wid * 2048 + 1024); } while (0)
    DMA_K(0, 0); DMA_V(0, 0);
    if (NT > 1) { DMA_K(1, 1); DMA_V(1, 1); }
    if (NT > 2) { DMA_K(2, 2); DMA_V(2, 2); }
    if (NT > 3) DMA_K(3, 3);
    const unsigned offk0 = (unsigned)(r32 * 128 + ((hi ^ ((r32 >> 1) & 7)) << 4));
#define OFFK(ks) (offk0 ^ (32u * (ks)))
    f32x16 o[4], s0, s1, negm;
#pragma unroll
    for (int r = 0; r < 16; ++r) { o[0][r] = 0.f; o[1][r] = 0.f; o[2][r] = 0.f; o[3][r] = 0.f; negm[r] = 0.f; }
    float mref = 0.f, lrun = 0.f;
    bf16x8 pf[4];
#define RD128(dst, addr, imm) asm volatile("ds_read_b128 %0, %1 offset:%c2" : "=&v"(dst) : "v"(addr), "i"(imm) : "memory")
#define LW4(n, X) asm volatile("s_waitcnt lgkmcnt(" #n ")" : "+v"(X[0]), "+v"(X[1]), "+v"(X[2]), "+v"(X[3]) :: "memory")
#define SB() __builtin_amdgcn_sched_barrier(0)
#define MF(a, b, c) __builtin_amdgcn_mfma_f32_32x32x16_bf16(a, b, c, 0, 0, 0)
    const unsigned ldsb = (unsigned)(uintptr_t)lds;
    bf16x8 gA[4], gB[4], gC[4];
#define RDV(G, va) do { RD128(G[0], va, 0); RD128(G[1], va, 4096); RD128(G[2], va, 8192); RD128(G[3], va, 12288); } while (0)
#define RDK(G, ka, c0, c1) do { RD128(G[0], ka + OFFK(c0), 0); RD128(G[1], ka + OFFK(c0), 4096); RD128(G[2], ka + OFFK(c1), 0); RD128(G[3], ka + OFFK(c1), 4096); } while (0)
#define PV4(G, p) do { o[0] = MF(G[0], p, o[0]); o[1] = MF(G[1], p, o[1]); o[2] = MF(G[2], p, o[2]); o[3] = MF(G[3], p, o[3]); SB(); } while (0)
#define ATT_S0() do { const unsigned ka_ = ldsb + map * 8192; \
        RDK(gA, ka_, 0, 1); RDK(gB, ka_, 2, 3); \
        LW4(4, gA); s0 = MF(gA[0], qf[0], negm); s1 = MF(gA[1], qf[0], negm); s0 = MF(gA[2], qf[1], s0); s1 = MF(gA[3], qf[1], s1); SB(); \
        LW4(0, gB); s0 = MF(gB[0], qf[2], s0); s1 = MF(gB[1], qf[2], s1); s0 = MF(gB[2], qf[3], s0); s1 = MF(gB[3], qf[3], s1); SB(); } while (0)
#define ATT_ISSUE(vslot) do { const unsigned vb_ = ldsb + ATT_VRING + (vslot) * 16384; \
        RDV(gA, vb_ + OFFK(0)); RDV(gB, vb_ + OFFK(1)); RDV(gC, vb_ + OFFK(2)); } while (0)
#define ATT_CONSUME(vslot, kslot, DO_S) do { const unsigned vb_ = ldsb + ATT_VRING + (vslot) * 16384, ka_ = ldsb + (kslot) * 16384 + map * 8192; \
        LW4(8, gA); PV4(gA, pf[0]); RDV(gA, vb_ + OFFK(3)); \
        if (DO_S) { \
            LW4(8, gB); PV4(gB, pf[1]); RDK(gB, ka_, 0, 1); \
            LW4(8, gC); PV4(gC, pf[2]); RDK(gC, ka_, 2, 3); \
            LW4(8, gA); PV4(gA, pf[3]); \
            LW4(4, gB); s0 = MF(gB[0], qf[0], negm); s1 = MF(gB[1], qf[0], negm); s0 = MF(gB[2], qf[1], s0); s1 = MF(gB[3], qf[1], s1); SB(); \
            LW4(0, gC); s0 = MF(gC[0], qf[2], s0); s1 = MF(gC[1], qf[2], s1); s0 = MF(gC[2], qf[3], s0); s1 = MF(gC[3], qf[3], s1); SB(); \
        } else { LW4(8, gB); PV4(gB, pf[1]); LW4(4, gC); PV4(gC, pf[2]); LW4(0, gA); PV4(gA, pf[3]); } } while (0)
#define MAX3(a, b, c) ({ float r_; asm("v_max3_f32 %0, %1, %2, %3" : "=v"(r_) : "v"(a), "v"(b), "v"(c)); r_; })
#define ATT_SOFTMAX(first) do { \
        asm volatile("s_nop 15\n\ts_nop 7" : "+v"(s0), "+v"(s1));                 \
        float ma_ = MAX3(s0[0], s0[1], s0[2]), mb_ = MAX3(s0[3], s0[4], s0[5]); \
        ma_ = MAX3(ma_, s0[6], s0[7]); mb_ = MAX3(mb_, s0[8], s0[9]); ma_ = MAX3(ma_, s0[10], s0[11]); mb_ = MAX3(mb_, s0[12], s0[13]); ma_ = MAX3(ma_, s0[14], s0[15]); \
        mb_ = MAX3(mb_, s1[0], s1[1]); ma_ = MAX3(ma_, s1[2], s1[3]); mb_ = MAX3(mb_, s1[4], s1[5]); ma_ = MAX3(ma_, s1[6], s1[7]); \
        mb_ = MAX3(mb_, s1[8], s1[9]); ma_ = MAX3(ma_, s1[10], s1[11]); mb_ = MAX3(mb_, s1[12], s1[13]); ma_ = MAX3(ma_, s1[14], s1[15]); \
        float mx_ = MAX3(ma_, mb_, mb_); \
        { auto rr_ = __builtin_amdgcn_permlane32_swap(__float_as_uint(mx_), __float_as_uint(mx_), false, false); const float x0_ = __uint_as_float(rr_[0]), x1_ = __uint_as_float(rr_[1]); mx_ = MAX3(x0_, x1_, x1_); } \
        if (first) { mref = mx_; \
            _Pragma("unroll") for (int r = 0; r < 16; ++r) { s0[r] -= mx_; s1[r] -= mx_; negm[r] = -mref; } } \
        else if (__any(mx_ > ATT_THR)) { \
            const float dl_ = (mx_ > 0.f) ? mx_ : 0.f; const float al_ = fast_exp2(-dl_); mref += dl_; lrun *= al_; \
            _Pragma("unroll") for (int r = 0; r < 16; ++r) { s0[r] -= dl_; s1[r] -= dl_; negm[r] = -mref; } \
            _Pragma("unroll") for (int eb = 0; eb < 4; ++eb) _Pragma("unroll") for (int r = 0; r < 16; ++r) o[eb][r] *= al_; } \
        float ls_ = 0.f; \
        _Pragma("unroll") for (int r = 0; r < 16; ++r) { s0[r] = fast_exp2(s0[r]); s1[r] = fast_exp2(s1[r]); ls_ += s0[r] + s1[r]; } \
        lrun += ls_; \
        _Pragma("unroll") for (int s = 0; s < 2; ++s) { u32x4 w_; \
            w_.x = cvt_pk_bf16(s0[8 * s + 0], s0[8 * s + 1]); w_.y = cvt_pk_bf16(s0[8 * s + 2], s0[8 * s + 3]); w_.z = cvt_pk_bf16(s0[8 * s + 4], s0[8 * s + 5]); w_.w = cvt_pk_bf16(s0[8 * s + 6], s0[8 * s + 7]); \
            pf[s] = __builtin_bit_cast(bf16x8, w_); \
            w_.x = cvt_pk_bf16(s1[8 * s + 0], s1[8 * s + 1]); w_.y = cvt_pk_bf16(s1[8 * s + 2], s1[8 * s + 3]); w_.z = cvt_pk_bf16(s1[8 * s + 4], s1[8 * s + 5]); w_.w = cvt_pk_bf16(s1[8 * s + 6], s1[8 * s + 7]); \
            pf[2 + s] = __builtin_bit_cast(bf16x8, w_); } } while (0)
#define ADDF(a, b) ({ float r_; asm("v_add_f32 %0, %1, %2" : "=v"(r_) : "v"(a), "v"(b)); r_; })
#define SUM8(X, b) ADDF(ADDF(ADDF(X[b], X[b + 1]), ADDF(X[b + 2], X[b + 3])), ADDF(ADDF(X[b + 4], X[b + 5]), ADDF(X[b + 6], X[b + 7])))
#define MFN(d, a, b, c) asm volatile("v_mfma_f32_32x32x16_bf16 %0, %1, %2, %3" : "=&v"(d) : "v"(a), "v"(b), "v"(c))
#define EX4(X, b) do { X[b] = fast_exp2(X[b]); X[b + 1] = fast_exp2(X[b + 1]); X[b + 2] = fast_exp2(X[b + 2]); X[b + 3] = fast_exp2(X[b + 3]); } while (0)
#define CV8(dst, X, b) do { u32x4 w_; w_.x = cvt_pk_bf16(X[b], X[b + 1]); w_.y = cvt_pk_bf16(X[b + 2], X[b + 3]); w_.z = cvt_pk_bf16(X[b + 4], X[b + 5]); w_.w = cvt_pk_bf16(X[b + 6], X[b + 7]); dst = __builtin_bit_cast(bf16x8, w_); } while (0)
#define ATT_UNI(vslot, kslot) do { const unsigned vb_ = ldsb + ATT_VRING + (vslot) * 16384, ka_ = ldsb + (kslot) * 16384 + map * 8192; \
        RDK(gA, ka_, 0, 1); RDK(gB, ka_, 2, 3); RDV(gC, vb_ + OFFK(0)); \
        __builtin_amdgcn_s_setprio(2); \
        LW4(8, gA); MFN(s0, gA[0], qf[0], negm); MFN(s1, gA[1], qf[0], negm); s0 = MF(gA[2], qf[1], s0); s1 = MF(gA[3], qf[1], s1); SB(); \
        RDV(gA, vb_ + OFFK(1)); \
        LW4(8, gB); s0 = MF(gB[0], qf[2], s0); s1 = MF(gB[1], qf[2], s1); s0 = MF(gB[2], qf[3], s0); s1 = MF(gB[3], qf[3], s1); SB(); \
        RDV(gB, vb_ + OFFK(2)); \
        __builtin_amdgcn_s_setprio(0); \
        LW4(8, gC); o[0] = MF(gC[0], pf[0], o[0]); o[1] = MF(gC[1], pf[0], o[1]); SB(); \
        asm volatile("s_nop 15\n\ts_nop 7" : "+v"(s0), "+v"(s1)); \
        float ma_ = MAX3(s0[0], s0[1], s0[2]), mb_ = MAX3(s0[3], s0[4], s0[5]); ma_ = MAX3(ma_, s0[6], s0[7]); mb_ = MAX3(mb_, s0[8], s0[9]); SB(); \
        o[2] = MF(gC[2], pf[0], o[2]); SB(); \
        ma_ = MAX3(ma_, s0[10], s0[11]); mb_ = MAX3(mb_, s0[12], s0[13]); ma_ = MAX3(ma_, s0[14], s0[15]); mb_ = MAX3(mb_, s1[0], s1[1]); ma_ = MAX3(ma_, s1[2], s1[3]); mb_ = MAX3(mb_, s1[4], s1[5]); SB(); \
        o[3] = MF(gC[3], pf[0], o[3]); SB(); \
        RDV(gC, vb_ + OFFK(3)); \
        ma_ = MAX3(ma_, s1[6], s1[7]); mb_ = MAX3(mb_, s1[8], s1[9]); ma_ = MAX3(ma_, s1[10], s1[11]); mb_ = MAX3(mb_, s1[12], s1[13]); ma_ = MAX3(ma_, s1[14], s1[15]); \
        float mx_ = MAX3(ma_, mb_, mb_); \
        { auto rr_ = __builtin_amdgcn_permlane32_swap(__float_as_uint(mx_), __float_as_uint(mx_), false, false); const float x0_ = __uint_as_float(rr_[0]), x1_ = __uint_as_float(rr_[1]); mx_ = MAX3(x0_, x1_, x1_); } \
        float alp_ = 1.0f; const bool resc_ = __any(mx_ > ATT_THR); \
        if (resc_) { const float dl_ = (mx_ > 0.f) ? mx_ : 0.f; alp_ = fast_exp2(-dl_); mref += dl_; lrun *= alp_; \
            _Pragma("unroll") for (int r = 0; r < 16; ++r) { s0[r] -= dl_; s1[r] -= dl_; negm[r] = -mref; } } \
        SB(); \
        LW4(8, gA); o[0] = MF(gA[0], pf[1], o[0]); SB(); EX4(s0, 0); SB(); o[1] = MF(gA[1], pf[1], o[1]); SB(); EX4(s0, 4); SB(); \
        o[2] = MF(gA[2], pf[1], o[2]); SB(); EX4(s0, 8); SB(); o[3] = MF(gA[3], pf[1], o[3]); SB(); EX4(s0, 12); SB(); \
        LW4(4, gB); o[0] = MF(gB[0], pf[2], o[0]); SB(); EX4(s1, 0); SB(); o[1] = MF(gB[1], pf[2], o[1]); SB(); EX4(s1, 4); SB(); \
        o[2] = MF(gB[2], pf[2], o[2]); SB(); EX4(s1, 8); SB(); o[3] = MF(gB[3], pf[2], o[3]); SB(); EX4(s1, 12); SB(); \
        float ls_; \
        LW4(0, gC); o[0] = MF(gC[0], pf[3], o[0]); SB(); \
        ls_ = SUM8(s0, 0); CV8(pf[0], s0, 0); SB(); \
        o[1] = MF(gC[1], pf[3], o[1]); SB(); \
        ls_ = ADDF(ls_, SUM8(s0, 8)); CV8(pf[1], s0, 8); SB(); \
        o[2] = MF(gC[2], pf[3], o[2]); SB(); \
        ls_ = ADDF(ls_, SUM8(s1, 0)); CV8(pf[2], s1, 0); SB(); \
        o[3] = MF(gC[3], pf[3], o[3]); SB(); \
        ls_ = ADDF(ls_, SUM8(s1, 8)); CV8(pf[3], s1, 8); SB(); \
        lrun += ls_; \
        if (resc_) { _Pragma("unroll") for (int eb = 0; eb < 4; ++eb) _Pragma("unroll") for (int r = 0; r < 16; ++r) o[eb][r] *= alp_; } } while (0)
    if (NT > 3) __builtin_amdgcn_s_waitcnt(0x0F7C); else __builtin_amdgcn_s_waitcnt(0x0F70);
    ATT_BAR();
    if (active) {
        ATT_S0();
#pragma unroll
        for (int r = 0; r < 16; ++r) s0[r] = -INFINITY;
#pragma unroll
        for (int r = 0; r < 8; ++r) s1[r] = -INFINITY;
        ATT_SOFTMAX(true);
    }
    att_wait_vm((NT > 3 ? 2 : 0) + (NT > 2 ? 4 : 0) + (NT > 1 ? 2 : 0));
    int k3 = 0;
#define ATT_HEAD(k) ATT_BAR();                             \
        const int k3p1 = (k3 + 1) & 3; \
        if ((k) + 4 < NT) DMA_K((k) + 4, k3);              \
        if ((k) + 3 < NT) DMA_V((k) + 3, (k3 + 3) & 3);
#define ATT_TAIL(k) att_wait_vm(((k) + 4 < NT ? 2 : 0) + ((k) + 3 < NT ? 4 : 0) + ((k) + 2 < NT ? 2 : 0));     \
        k3 = k3p1;
    for (int k = 0; k < tmax; ++k) {
        ATT_HEAD(k)
        ATT_UNI(k3, k3p1);
        ATT_TAIL(k)
    }
    { ATT_HEAD(tmax)
      ATT_ISSUE(k3);
      ATT_CONSUME(k3, k3p1, false);
      ATT_TAIL(tmax) }
    if (tmax < NT - 1) { ATT_BAR(); att_wait_vm(0); }
#undef ATT_HEAD
#undef ATT_TAIL
#undef DMA16
#undef TILE_ROW0
#undef OFFK
#undef DMA_K
#undef DMA_V
#undef ATT_S0
#undef ATT_ISSUE
#undef ATT_CONSUME
#undef PV4
#undef RDV
#undef RDK
#undef RD128
#undef LW4
#undef SB
#undef MF
#undef ATT_SOFTMAX
#undef MAX3
#undef ATT_UNI
#undef EX4
#undef MFN
#undef ADDF
#undef SUM8
#undef CV8
    { auto rr = __builtin_amdgcn_permlane32_swap(__float_as_uint(lrun), __float_as_uint(lrun), false, false); lrun = __uint_as_float(rr[0]) + __uint_as_float(rr[1]); }
    const float inv = 1.0f / lrun;
    LAS float* ex = (LAS float*)(lds + sub * ATT_XSTRIDE);
    const int e0 = (lane & 15) * 8;
    u32x4 zreg[8]; f32x4 ga, gb;
    if (map == 0) {
        ga = *(const f32x4*)(subg + e0); gb = *(const f32x4*)(subg + e0 + 4);
#pragma unroll
        for (int ps = 0; ps < 8; ++ps) zreg[ps] = __builtin_nontemporal_load((const u32x4*)(Zs + (qbase + 32 * sub + ps * 4 + (lane >> 4)) * DM + h * 128 + e0));
    }
    ATT_BAR();
    if (active && map == 1) {
        const float f = inv * lam;
#pragma unroll
        for (int eb = 0; eb < 4; ++eb)
#pragma unroll
            for (int rq = 0; rq < 4; ++rq) { f32x4 v; v[0] = o[eb][4 * rq] * f; v[1] = o[eb][4 * rq + 1] * f; v[2] = o[eb][4 * rq + 2] * f; v[3] = o[eb][4 * rq + 3] * f;
                *(LAS f32x4*)(ex + r32 * 132 + 32 * eb + 8 * rq + 4 * hi) = v; }
    }
    ATT_BAR();
    if (active && map == 0) {
        float ssq = 0.f;
#pragma unroll
        for (int eb = 0; eb < 4; ++eb)
#pragma unroll
            for (int rq = 0; rq < 4; ++rq) { const f32x4 x = *(const LAS f32x4*)(ex + r32 * 132 + 32 * eb + 8 * rq + 4 * hi);
#pragma unroll
                for (int j = 0; j < 4; ++j) { const float v = o[eb][4 * rq + j] * inv - x[j]; o[eb][4 * rq + j] = v; ssq += v * v; } }
        { auto rr = __builtin_amdgcn_permlane32_swap(__float_as_uint(ssq), __float_as_uint(ssq), false, false); ssq = __uint_as_float(rr[0]) + __uint_as_float(rr[1]); }
        const float rn = rsqrtf(ssq * (1.0f / 128.0f) + EPS) * oml;
#pragma unroll
        for (int eb = 0; eb < 4; ++eb)
#pragma unroll
            for (int rq = 0; rq < 4; ++rq) { f32x4 v; v[0] = o[eb][4 * rq] * rn; v[1] = o[eb][4 * rq + 1] * rn; v[2] = o[eb][4 * rq + 2] * rn; v[3] = o[eb][4 * rq + 3] * rn;
                *(LAS f32x4*)(ex + r32 * 132 + 32 * eb + 8 * rq + 4 * hi) = v; }
        asm volatile("s_waitcnt lgkmcnt(0)" ::: "memory");
#pragma unroll
        for (int ps = 0; ps < 8; ++ps) {
            const int q = ps * 4 + (lane >> 4);
            const size_t row = qbase + 32 * sub + q;
            const f32x4 xa = *(const LAS f32x4*)(ex + q * 132 + e0), xb = *(const LAS f32x4*)(ex + q * 132 + e0 + 4);
            const u32x4 z = zreg[ps];
            u32x4 w;
            w.x = cvt_pk_bf16(xa[0] * ga[0] * bf_lo(z.x), xa[1] * ga[1] * bf_hi(z.x)); w.y = cvt_pk_bf16(xa[2] * ga[2] * bf_lo(z.y), xa[3] * ga[3] * bf_hi(z.y));
            w.z = cvt_pk_bf16(xb[0] * gb[0] * bf_lo(z.z), xb[1] * gb[1] * bf_hi(z.z)); w.w = cvt_pk_bf16(xb[2] * gb[2] * bf_lo(z.w), xb[3] * gb[3] * bf_hi(z.w));
            *(u32x4*)(Ob + row * DM + h * 128 + e0) = w;
        }
    }
    ATT_BAR();
}
__device__ __forceinline__ void attn_phase(LAS unsigned char* lds, const bf16_t* Qb, const bf16_t* Kb, const bf16_t* Vt, const bf16_t* Zs, bf16_t* Ob, const float* subg, float lam, float oml, int vcu, int G) {
    for (int P = vcu; P < 1024; P += G) {
        const int bh = P >> 3, s = P & 7;
        for (int u = 0; u < 2; ++u) attn_unit(lds, Qb, Kb, Vt, Zs, Ob, subg, lam, oml, bh >> 3, bh & 7, u ? 15 - s : s);
    }
}
struct Args {
    const float *x, *meta, *a_norm_g, *a_w_in, *a_conv_w, *a_conv_b, *a_w_out, *kv_norm_g, *w_kv, *b_norm_g, *b_w_in, *lq1, *lk1, *lq2, *lk2, *subln_g, *b_w_out, *final_g;
    float* out; unsigned char* ws;
};
struct TrItem { const float* src; const float* g; bf16_t* dst; int N; };
__device__ __forceinline__ TrItem tr_decode(const Args& a, int it, int lane) {
    unsigned char* ws = a.ws;
    constexpr int I_AIN = 16 * 64, I_SQ = 16 * 16, I_BIN = 16 * 32;
    const float* W; const float* g; bf16_t* WT; int N, col_off = 0, row_off = 0, nblk; bool perma = false;
    int r = it;
    if (r < 2 * I_AIN) { const int l = r / I_AIN; r -= l * I_AIN; W = a.a_w_in + (size_t)l * DM * 4096; N = 4096; g = a.a_norm_g + l * DM; WT = (bf16_t*)(ws + WS_WAIN) + (size_t)l * 4096 * DM; nblk = 64; perma = true; }
    else { r -= 2 * I_AIN;
    if (r < 2 * I_SQ) { const int l = r / I_SQ; r -= l * I_SQ; W = a.a_w_out + (size_t)l * DM * DM; N = DM; g = nullptr; WT = (bf16_t*)(ws + WS_WAOUT) + (size_t)l * DM * DM; nblk = 16; }
    else { r -= 2 * I_SQ;
    if (r < I_SQ) { W = a.w_kv; N = 2048; g = a.kv_norm_g; WT = (bf16_t*)(ws + WS_WKQZ); nblk = 16; }
    else { r -= I_SQ;
    if (r < I_SQ) { W = a.w_kv; N = 2048; col_off = 1024; g = a.kv_norm_g; WT = (bf16_t*)(ws + WS_WVT); nblk = 16; }
    else { r -= I_SQ;
    if (r < I_BIN) { W = a.b_w_in; N = 2048; g = a.b_norm_g; WT = (bf16_t*)(ws + WS_WKQZ); row_off = 1024; nblk = 32; }
    else { r -= I_BIN;
    if (r < I_BIN) { W = a.b_w_in + (size_t)DM * 2048; N = 2048; g = a.b_norm_g + DM; WT = (bf16_t*)(ws + WS_WQZ1); nblk = 32; }
    else { r -= I_BIN; const int l = r / I_SQ; r -= l * I_SQ; W = a.b_w_out + (size_t)l * DM * DM; N = DM; g = nullptr; WT = (bf16_t*)(ws + WS_WBOUT) + (size_t)l * DM * DM; nblk = 16; } } } } } }
    const int kb = r / nblk, nb = r - kb * nblk, k0 = 64 * kb, n0 = 64 * nb, nq = lane & 15, kr = lane >> 4;
    const int np = n0 + 4 * nq; int src;
    if (perma) { const int pn = np >> 8, bj = (np >> 7) & 1, wc = (np >> 5) & 3, nn = (np >> 4) & 1, low = np & 15; src = (2 * bj + nn) * 1024 + 64 * pn + 16 * wc + low; }
    else src = col_off + np;
    TrItem t; t.src = W + (size_t)(k0 + kr) * N + src; t.g = g ? g + k0 : nullptr; t.dst = WT + (size_t)(row_off + n0) * DM + k0; t.N = N;
    return t;
}
__device__ __forceinline__ void tr_load(const TrItem& t, f32x4 (&v)[16]) {
#pragma unroll
    for (int i = 0; i < 16; ++i) v[i] = __builtin_nontemporal_load((const f32x4*)(t.src + (size_t)(4 * i) * t.N));
}
__device__ __forceinline__ void tr_store(const TrItem& t, const f32x4 (&v)[16], LAS float* scr, int lane) {
    const int nq = lane & 15, kr = lane >> 4;
#pragma unroll
    for (int i = 0; i < 16; ++i) { const int kk = 4 * i + kr; const float gg = t.g ? t.g[kk] : 1.0f;
        scr[kk * 65 + 4 * nq + 0] = v[i][0] * gg; scr[kk * 65 + 4 * nq + 1] = v[i][1] * gg; scr[kk * 65 + 4 * nq + 2] = v[i][2] * gg; scr[kk * 65 + 4 * nq + 3] = v[i][3] * gg; }
    asm volatile("s_waitcnt lgkmcnt(0)" ::: "memory");
    const int c = lane & 7;
#pragma unroll
    for (int j = 0; j < 8; ++j) { const int n = (lane >> 3) + 8 * j; const LAS float* s = scr + (8 * c) * 65 + n;
        u32x4 o; o.x = cvt_pk_bf16(s[0 * 65], s[1 * 65]); o.y = cvt_pk_bf16(s[2 * 65], s[3 * 65]); o.z = cvt_pk_bf16(s[4 * 65], s[5 * 65]); o.w = cvt_pk_bf16(s[6 * 65], s[7 * 65]);
        *(u32x4*)(t.dst + (size_t)n * DM + 8 * c) = o; }
    asm volatile("s_waitcnt lgkmcnt(0)" ::: "memory");
}
__device__ __forceinline__ void prologue(const Args& a, LAS unsigned char* lds, int gw, int NGW, int wave, int lane) {
    LAS float* scr = (LAS float*)(lds + wave * 16640);
    unsigned char* ws = a.ws;
    constexpr int NITEMS = 2 * (16 * 64) + 2 * 256 + 2 * 256 + 2 * (16 * 32) + 2 * 256;
    if (gw < NITEMS) {
        TrItem cur = tr_decode(a, gw, lane); f32x4 v[16]; tr_load(cur, v);
        for (int it = gw; it < NITEMS; it += NGW) {
            const bool more = it + NGW < NITEMS;
            TrItem nxt = cur; f32x4 vn[16];
            if (more) { nxt = tr_decode(a, it + NGW, lane); tr_load(nxt, vn); }
            tr_store(cur, v, scr, lane);
            if (more) { cur = nxt;
#pragma unroll
                for (int i = 0; i < 16; ++i) v[i] = vn[i]; }
        }
    }
    bf16_t* hb = (bf16_t*)(ws + WS_HB); float* part = (float*)(ws + WS_SS);
#define H0_LOAD(dst, r0) do { _Pragma("unroll") for (int q = 0; q < 4; ++q) { const int row_ = (r0) + q; const float* src_ = (row_ < MF) ? a.x + (size_t)row_ * DM : a.meta + (size_t)(row_ - MF) * DM; \
        _Pragma("unroll") for (int j = 0; j < 4; ++j) dst[q][j] = __builtin_nontemporal_load((const f32x4*)(src_ + 4 * lane + 256 * j)); } } while (0)
    if (gw * 4 < MF + NMETA) {
        f32x4 v[4][4]; H0_LOAD(v, gw * 4);
        for (int row0 = gw * 4; row0 < MF + NMETA; row0 += NGW * 4) {
            const bool more = row0 + NGW * 4 < MF + NMETA;
            f32x4 vn[4][4];
            if (more) H0_LOAD(vn, row0 + NGW * 4);
#pragma unroll
            for (int q = 0; q < 4; ++q) { const int row = row0 + q; float ss = 0.f;
#pragma unroll
                for (int j = 0; j < 4; ++j) { const f32x4 x = v[q][j];
                    ss += (x[0] * x[0] + x[1] * x[1]) + (x[2] * x[2] + x[3] * x[3]);
                    u32x2 w; w.x = cvt_pk_bf16(x[0], x[1]); w.y = cvt_pk_bf16(x[2], x[3]);
                    *(u32x2*)(hb + (size_t)row * DM + 4 * lane + 256 * j) = w; }
                ss = wave_sum(ss);
                if (lane < 16) part[(size_t)row * 16 + lane] = (lane == 0) ? ss : 0.f; }
            if (more) {
#pragma unroll
                for (int q = 0; q < 4; ++q)
#pragma unroll
                    for (int j = 0; j < 4; ++j) v[q][j] = vn[q][j]; }
        }
    }
#undef H0_LOAD
}
__device__ __forceinline__ void conv_phase(const bf16_t* __restrict__ v, const bf16_t* __restrict__ gz, bf16_t* __restrict__ y, const float* __restrict__ cw, const float* __restrict__ cb, int bid, int G, int tid) {
    const int cg8 = (tid & 127) * 8, rsub = tid >> 7;
    float w0[8], w1[8], w2[8], bb[8];
#pragma unroll
    for (int i = 0; i < 8; ++i) { w0[i] = cw[cg8 + i]; w1[i] = cw[DM + cg8 + i]; w2[i] = cw[2 * DM + cg8 + i]; bb[i] = cb[cg8 + i]; }
    for (int i = bid * 4 + rsub; i < MF / 32 + NMETA; i += G * 4) {
        const int r = (i < MF / 32) ? (i >> 1) * 64 + (i & 1) : MF + (i - MF / 32);
        int r1, r2;
        if (r < MF) { const int t = r & (SEQ - 1); r1 = (t >= 1) ? r - 1 : HM + 15; r2 = (t >= 2) ? r - 2 : HM + 14 + t; }
        else { const int mm = r - MF; r1 = (mm >= 1) ? r - 1 : -1; r2 = (mm >= 2) ? r - 2 : -1; }
        const u32x4 zero = (u32x4){0u, 0u, 0u, 0u};
        const u32x4 a0 = *(const u32x4*)(v + (size_t)r * DM + cg8);
        const u32x4 a1 = (r1 >= 0) ? *(const u32x4*)(v + (size_t)r1 * DM + cg8) : zero;
        const u32x4 a2 = (r2 >= 0) ? *(const u32x4*)(v + (size_t)r2 * DM + cg8) : zero;
        const u32x4 gg = *(const u32x4*)(gz + (size_t)r * DM + cg8);
        float o[8];
#pragma unroll
        for (int i = 0; i < 4; ++i) {
            const unsigned x0 = a0[i], x1 = a1[i], x2 = a2[i], gx = gg[i];
            o[2 * i] = bf_lo(gx) * (w0[2 * i] * bf_lo(x2) + w1[2 * i] * bf_lo(x1) + w2[2 * i] * bf_lo(x0) + bb[2 * i]);
            o[2 * i + 1] = bf_hi(gx) * (w0[2 * i + 1] * bf_hi(x2) + w1[2 * i + 1] * bf_hi(x1) + w2[2 * i + 1] * bf_hi(x0) + bb[2 * i + 1]);
        }
        u32x4 w; w.x = cvt_pk_bf16(o[0], o[1]); w.y = cvt_pk_bf16(o[2], o[3]); w.z = cvt_pk_bf16(o[4], o[5]); w.w = cvt_pk_bf16(o[6], o[7]);
        *(u32x4*)(y + (size_t)r * DM + cg8) = w;
    }
}
__device__ __forceinline__ void final_phase(const bf16_t* __restrict__ hb, const float* __restrict__ part, const float* __restrict__ fg, float* __restrict__ out, int gw, int NGW, int lane) {
    f32x4 g[4];
#pragma unroll
    for (int j = 0; j < 2; ++j) { g[2 * j] = *(const f32x4*)(fg + 8 * lane + 512 * j); g[2 * j + 1] = *(const f32x4*)(fg + 8 * lane + 512 * j + 4); }
    for (int orow = gw; orow < MF; orow += NGW) {
        const size_t row = (size_t)orow;
        float s = part[row * 16 + (lane & 15)];
        s += __shfl_xor(s, 1); s += __shfl_xor(s, 2); s += __shfl_xor(s, 4); s += __shfl_xor(s, 8);
        const float rs = rsqrtf(s * (1.0f / DM) + EPS);
#pragma unroll
        for (int j = 0; j < 2; ++j) {
            const u32x4 hv = __builtin_nontemporal_load((const u32x4*)(hb + row * DM + 8 * lane + 512 * j));
            f32x4 o0, o1;
            o0[0] = bf_lo(hv.x) * rs * g[2 * j][0]; o0[1] = bf_hi(hv.x) * rs * g[2 * j][1]; o0[2] = bf_lo(hv.y) * rs * g[2 * j][2]; o0[3] = bf_hi(hv.y) * rs * g[2 * j][3];
            o1[0] = bf_lo(hv.z) * rs * g[2 * j + 1][0]; o1[1] = bf_hi(hv.z) * rs * g[2 * j + 1][1]; o1[2] = bf_lo(hv.w) * rs * g[2 * j + 1][2]; o1[3] = bf_hi(hv.w) * rs * g[2 * j + 1][3];
            __builtin_nontemporal_store(o0, (f32x4*)(out + (size_t)orow * DM + 8 * lane + 512 * j)); __builtin_nontemporal_store(o1, (f32x4*)(out + (size_t)orow * DM + 8 * lane + 512 * j + 4));
        }
    }
}
typedef const __attribute__((address_space(4))) Args* CArgsP;
#define AP() ({ CArgsP p_ = (CArgsP)__builtin_amdgcn_kernarg_segment_ptr(); asm volatile("" : "+s"(p_)); p_; })
#define WSB(off) ((bf16_t*)(ws + (off)))
#define GRID_BAR() do { XcdBarrier bb_; bb_.bar = (unsigned*)(AP()->ws + WS_CTL); bb_.x = xb_xcc_id(); bb_.st = (volatile LAS unsigned*)(lds + 131072 + 128); xcd_barrier(bb_); } while (0)
__global__ void __launch_bounds__(512, 2) yoco_fwd(Args a_unused) {
    extern __shared__ __attribute__((aligned(16))) unsigned char lds_raw[];
    LAS unsigned char* lds = (LAS unsigned char*)lds_raw;
    cg::grid_group grid = cg::this_grid();
    const int G = gridDim.x, bx = blockIdx.x;
    const int vcu = (G % 8 == 0) ? (bx % 8) * (G / 8) + bx / 8 : bx;
    {
        CArgsP ap = AP(); unsigned char* ws = ap->ws;
        int tid = threadIdx.x; asm volatile("" : "+v"(tid));
        const int lane = tid & 63, wave = __builtin_amdgcn_readfirstlane(tid >> 6);
        if (bx == 0) { for (int i = tid; i < 4096; i += 512) ((unsigned*)(ws + WS_CTL))[i] = 0u; }
        Args acopy; { const __attribute__((address_space(4))) unsigned long long* s_ = (const __attribute__((address_space(4))) unsigned long long*)ap; unsigned long long* d_ = (unsigned long long*)&acopy;
#pragma unroll
          for (int i = 0; i < (int)(sizeof(Args) / 8); ++i) d_[i] = s_[i]; }
        prologue(acopy, lds, vcu * 8 + wave, G * 8, wave, lane);
        __syncthreads();
        if (tid < 2) ((volatile LAS unsigned*)(lds + 131072 + 128))[tid] = 0u;
    }
    grid.sync();
    if (threadIdx.x == 0) { const unsigned r_ = xb_add((unsigned*)(AP()->ws + WS_CTL) + XB_XCNT(xb_xcc_id()), 1u); ((volatile LAS unsigned*)(lds + 131072 + 128))[2] = r_; }
    __syncthreads();
#define REAL_CU(out_c, out_v) do { unsigned* bar_ = (unsigned*)(AP()->ws + WS_CTL); bool ok_ = (G % 8 == 0); \
        for (int j_ = 0; j_ < 8; ++j_) ok_ = ok_ && (xb_ld(&bar_[XB_XCNT(j_)]) == (unsigned)(G / 8)); \
        const int x_ = (int)xb_xcc_id(), r_ = (int)((volatile LAS unsigned*)(lds + 131072 + 128))[2]; \
        ok_ = ok_ && x_ < 8 && r_ < G / 8; \
        out_c = ok_ ? r_ * 8 + x_ : bx;                   \
        out_v = ok_ ? x_ * (G / 8) + r_ : vcu;            \
        out_c = __builtin_amdgcn_readfirstlane(out_c); out_v = __builtin_amdgcn_readfirstlane(out_v); } while (0)
#pragma unroll 1
    for (int layer = 0; layer < 4; ++layer) {
        if (layer < 2) {
            { CArgsP ap = AP(); unsigned char* ws = ap->ws; bf16_t* hb = WSB(WS_HB); float* part = (float*)(ws + WS_SS);
              const bf16_t* Wl = WSB(WS_WAIN) + (size_t)layer * 4096 * DM;
              int t2 = threadIdx.x; asm volatile("" : "+v"(t2));
              if (vcu < 64) meta_ain_job(vcu, hb, Wl, part, WSB(WS_BUF0), WSB(WS_BUF1), __builtin_amdgcn_readfirstlane(t2 >> 6), t2 & 63, lds);
              pg8::Gemm g{hb, Wl, MF, 4096, DM}; pg8::StaticOrder S; S.init(MF, 4096, G, bx);
              EpiAIn E{part, WSB(WS_BUF0), WSB(WS_BUF1), WSB(WS_BUF2), ap->a_conv_w + (size_t)layer * 3 * DM, ap->a_conv_b + (size_t)layer * DM};
              pg8::gemm_phase<EpiAIn, pg8::StaticOrder, true, true>(lds, g, S, E); }
            GRID_BAR();
            { CArgsP ap = AP(); unsigned char* ws = ap->ws; int t2 = threadIdx.x; asm volatile("" : "+v"(t2));
              conv_phase(WSB(WS_BUF0), WSB(WS_BUF1), WSB(WS_BUF2), ap->a_conv_w + (size_t)layer * 3 * DM, ap->a_conv_b + (size_t)layer * DM, bx, G, t2); }
            GRID_BAR();
        } else {
            const int lb = layer - 2;
            if (lb == 0) {
              CArgsP ap = AP(); unsigned char* ws = ap->ws; bf16_t* hb = WSB(WS_HB); float* part = (float*)(ws + WS_SS);
              int t2 = threadIdx.x; asm volatile("" : "+v"(t2)); const int wv = __builtin_amdgcn_readfirstlane(t2 >> 6);
              if (bx == G - 1) { for (int i = t2; i < PADR * DM / 8; i += 512) *(u32x4*)(WSB(WS_BUF0) + (size_t)KM * DM + (size_t)i * 8) = (u32x4){0u, 0u, 0u, 0u}; }
              if (bx == G - 2) { for (int i = t2; i < 1024 * 6; i += 512) *(u32x4*)(WSB(WS_BUF3) + (size_t)(i / 6) * VP + MF + (i % 6) * 8) = (u32x4){0u, 0u, 0u, 0u}; }
              if (vcu < 16) meta_k_job(vcu, hb, WSB(WS_WKQZ), part, WSB(WS_BUF0), wv, t2 & 63, lds);
              else if (vcu < 32) meta_v_job(vcu - 16, hb, WSB(WS_WVT), part, WSB(WS_BUF3), wv, t2 & 63, lds); }
            { CArgsP ap = AP(); unsigned char* ws = ap->ws;
              pg8::Gemm g{WSB(WS_HB), lb ? WSB(WS_WQZ1) : WSB(WS_WKQZ), MF, lb ? 2048 : 3072, DM}; pg8::StaticOrder S; S.init(MF, lb ? 2048 : 3072, G, bx);
              EpiKQZ E{(const float*)(ws + WS_SS), WSB(WS_BUF0), lb ? 1 : 0};
              pg8::gemm_phase<EpiKQZ, pg8::StaticOrder, true, true>(lds, g, S, E); }
            if (lb == 0) {
              CArgsP ap = AP(); unsigned char* ws = ap->ws;
              pg8::Gemm g{WSB(WS_WVT), WSB(WS_HB), DM, MF, DM}; pg8::StaticOrder S; S.init(DM, MF, G, bx);
              EpiVt E{(const float*)(ws + WS_SS), WSB(WS_BUF3)};
              pg8::gemm_phase<EpiVt, pg8::StaticOrder, true, true>(lds, g, S, E); }
            GRID_BAR();
            { CArgsP ap = AP(); unsigned char* ws = ap->ws;
              float lam, oml;
              { int l2 = threadIdx.x; asm volatile("" : "+v"(l2)); l2 &= 63; const float p1 = ap->lq1[lb * 64 + l2] * ap->lk1[lb * 64 + l2], p2 = ap->lq2[lb * 64 + l2] * ap->lk2[lb * 64 + l2];
                const float li = 0.8f - 0.6f * expf(-0.3f * (float)layer);
                lam = expf(wave_sum(p1)) - expf(wave_sum(p2)) + li; oml = 1.0f - li;
                lam = __uint_as_float(__builtin_amdgcn_readfirstlane(__float_as_uint(lam))); oml = __uint_as_float(__builtin_amdgcn_readfirstlane(__float_as_uint(oml))); }
              int rc_, rv_; REAL_CU(rc_, rv_);
              attn_phase(lds, WSB(WS_BUF1), WSB(WS_BUF0), WSB(WS_BUF3), WSB(WS_BUF2), WSB(WS_BUF1), ap->subln_g + lb * 128, lam, oml, rv_, G); }
            GRID_BAR();
        }
        { CArgsP ap = AP(); unsigned char* ws = ap->ws; bf16_t* hb = WSB(WS_HB); float* part = (float*)(ws + WS_SS);
          const bf16_t* Aout = (layer < 2) ? WSB(WS_BUF2) : WSB(WS_BUF1);
          const bf16_t* Wout = (layer < 2) ? WSB(WS_WAOUT) + (size_t)layer * DM * DM : WSB(WS_WBOUT) + (size_t)(layer - 2) * DM * DM;
          int t2 = threadIdx.x; asm volatile("" : "+v"(t2));
          if (layer < 2 && vcu < 16) meta_res_job(vcu, Aout, Wout, hb, part, __builtin_amdgcn_readfirstlane(t2 >> 6), t2 & 63, lds);
          pg8::Gemm g{Aout, Wout, MF, DM, DM}; pg8::StaticOrder S; S.init(MF, DM, G, bx);
          EpiRes E{hb, part};
          pg8::gemm_phase<EpiRes, pg8::StaticOrder, true, true>(lds, g, S, E); }
        GRID_BAR();
    }
    { CArgsP ap = AP(); unsigned char* ws = ap->ws; int t2 = threadIdx.x; asm volatile("" : "+v"(t2));
      final_phase(WSB(WS_HB), (const float*)(ws + WS_SS), ap->final_g, ap->out, vcu * 8 + __builtin_amdgcn_readfirstlane(t2 >> 6), G * 8, t2 & 63); }
}

extern "C" void kernel_launch(void* const* d_in, const int* in_sizes, int n_in, void* d_out, int out_size, void* d_ws, size_t ws_size, hipStream_t stream) {
    static int grid = 0;
    if (grid == 0) {
        int dev = 0, cus = 0, per = 0;
        if (n_in != 18 || out_size != MF * DM || ws_size < WS_END) { fprintf(stderr, "kernel_launch: unexpected shapes (n_in %d out %d ws %zu)\n", n_in, out_size, ws_size); grid = -1; return; }
        (void)hipGetDevice(&dev); (void)hipDeviceGetAttribute(&cus, hipDeviceAttributeMultiprocessorCount, dev);
        (void)hipFuncSetAttribute((const void*)yoco_fwd, hipFuncAttributeMaxDynamicSharedMemorySize, LDS_BYTES);
        (void)hipOccupancyMaxActiveBlocksPerMultiprocessor(&per, (const void*)yoco_fwd, 512, LDS_BYTES);
        if (per < 1) per = 1;
        grid = cus * per;
        fprintf(stderr, "kernel_launch: grid %d (cus %d x %d)\n", grid, cus, per);
    }
    if (grid < 0) return;
    Args a{};
    const float** ap = (const float**)&a;
    for (int i = 0; i < 18; ++i) ap[i] = (const float*)d_in[i];
    a.out = (float*)d_out; a.ws = (unsigned char*)d_ws;
    void* args[] = {&a};
    hipError_t e = hipLaunchCooperativeKernel((const void*)yoco_fwd, dim3(grid), dim3(512), args, LDS_BYTES, stream);
    if (e != hipSuccess) fprintf(stderr, "cooperative launch failed: %s (grid %d)\n", hipGetErrorString(e), grid);
}
```

```cpp
#include <hip/hip_runtime.h>
#include <hip/hip_cooperative_groups.h>
#include <cstdio>
#include <cstdint>
namespace cg = cooperative_groups;
#define ATT_VCU vcu
namespace pg8 {
#define PG8_LAS __attribute__((address_space(3)))
typedef unsigned short bf16_t;
typedef short bf16x8 __attribute__((ext_vector_type(8)));
typedef float f32x4 __attribute__((ext_vector_type(4)));
typedef unsigned u32x4 __attribute__((ext_vector_type(4)));
constexpr int BM = 256, BK = 64, HALF = 128, HTB = HALF * BK * 2  , STAGE_BYTES = 8 * HTB, NXCD = 8, WGM = 4;

__host__ __device__ __forceinline__ int lds_byte(int r, int c) { const int st = (r >> 4) * 2 + (c >> 5), rr = r & 15, cc = c & 31, ob = rr * 64 + cc * 2; return st * 1024 + (ob ^ (((ob >> 9) & 1) << 5)); }
__host__ __device__ __forceinline__ void stage_rc(int b, int& R, int& C) { const int st = b / 1024, sb = b % 1024, swz = sb ^ (((sb >> 9) & 1) << 5); R = (st >> 1) * 16 + swz / 64; C = (st & 1) * 32 + (swz % 64) / 2; }
__host__ __device__ __forceinline__ int perm32(int rho) { const int n = rho >> 4, i = rho & 15; return 8 * (i >> 2) + 4 * n + (i & 3); }

struct Unit { int pm, pn; };
struct Gemm { const bf16_t* A; const bf16_t* Bt; int M, N, K; };

struct StaticOrder {
    int nM, nN, nwg, G, c;
    __host__ __device__ void init(int M, int N, int G_, int c_) { nM = M / BM; nN = N / BM; nwg = nM * nN; G = G_; c = c_; }
    __host__ __device__ bool next(int i, Unit& u) const {
        const long L = (long)i * G + c; if (L >= nwg) return false;
        int wgid = (int)L; { const int q = nwg / NXCD, r = nwg % NXCD, xcd = wgid % NXCD, off = wgid / NXCD; wgid = (xcd < r ? xcd * (q + 1) : r * (q + 1) + (xcd - r) * q) + off; }
        const int nig = WGM * nN, gid = wgid / nig, fm = gid * WGM, gsz = (nM - fm) < WGM ? (nM - fm) : WGM;
        u.pm = fm + ((wgid % nig) % gsz); u.pn = (wgid % nig) / gsz; return true;
    }
    __device__ __forceinline__ void a_ready(const Unit&) const {}
    __device__ __forceinline__ void done(const Unit&) const {}
};

__device__ __forceinline__ unsigned cvt_pk_bf16(float lo, float hi) { unsigned r; asm volatile("v_cvt_pk_bf16_f32 %0, %1, %2" : "=v"(r) : "v"(lo), "v"(hi)); return r; }
typedef float f32x2 __attribute__((ext_vector_type(2)));
template <class Epi, class Sched, bool ALIGN_EPI = false, bool SP2 = false>
__device__ __forceinline__ void gemm_phase(PG8_LAS unsigned char* lds, const Gemm g, const Sched& S, const Epi& E) {
    int tid = threadIdx.x; asm volatile("" : "+v"(tid)); const int wid = __builtin_amdgcn_readfirstlane(tid >> 6), lane = tid & 63, wr = wid >> 2, wc = wid & 3, fr = lane & 15, fq = lane >> 4;
    const int K = g.K, nt = K / BK;
    unsigned voffA[2], voffB[2];
#pragma unroll
    for (int i = 0; i < 2; ++i) { int R, C; stage_rc(tid * 16 + i * 8192, R, C); const int Rb = Epi::PERM ? ((R & ~31) + perm32(R & 31)) : R;
        voffA[i] = (unsigned)(R * K + C) * 2u; voffB[i] = (unsigned)(Rb * K + C) * 2u; }
    const size_t kstep = (size_t)(BK * 2);
    const size_t hstep = (size_t)HALF * K * 2;
    const size_t tstep = 2 * hstep;
    const unsigned ldsw = (unsigned)wid * 1024u;
    const int aoff = lds_byte(wr * 64 + fr, fq * 8), boff = lds_byte(wc * 32 + fr, fq * 8);
#define PG8_SA(b, h) (((b) * 2 + (h)) * HTB)
#define PG8_SB(b, h) ((4 + (b) * 2 + (h)) * HTB)
#define PG8_STAGE(bufoff, gbase, voff) do { _Pragma("unroll") for (int _i = 0; _i < 2; ++_i) \
        __builtin_amdgcn_global_load_lds((const unsigned*)((const char*)(gbase) + (voff)[_i]), (PG8_LAS unsigned*)(lds + (bufoff) + ldsw + _i * 8192), 16, 0, 0); } while (0)
#define PG8_LDA(dst, b, h) do { _Pragma("unroll") for (int m = 0; m < 4; ++m) _Pragma("unroll") for (int k = 0; k < 2; ++k) dst[m][k] = *(const PG8_LAS bf16x8*)(lds + PG8_SA(b, h) + aoff + m * 2048 + k * 1024); } while (0)
#define PG8_LDB(dst, b, h) do { _Pragma("unroll") for (int n = 0; n < 2; ++n) _Pragma("unroll") for (int k = 0; k < 2; ++k) dst[n][k] = *(const PG8_LAS bf16x8*)(lds + PG8_SB(b, h) + boff + n * 2048 + k * 1024); } while (0)
#define PG8_MMA(ai, bj, At, Bt) do { __builtin_amdgcn_s_setprio(1); _Pragma("unroll") for (int m = 0; m < 4; ++m) _Pragma("unroll") for (int n = 0; n < 2; ++n) _Pragma("unroll") for (int k = 0; k < 2; ++k) \
        acc[ai][bj][m][n] = __builtin_amdgcn_mfma_f32_16x16x32_bf16(Bt[n][k], At[m][k], acc[ai][bj][m][n], 0, 0, 0); __builtin_amdgcn_s_setprio(0); } while (0)
#define PG8_WAIT_V(n) asm volatile("s_waitcnt vmcnt(" #n ")" ::: "memory")
#define PG8_WAIT_L(n) asm volatile("s_waitcnt lgkmcnt(" #n ")" ::: "memory")
#define PG8_BAR __builtin_amdgcn_s_barrier()
#define PG8_SCHED __builtin_amdgcn_sched_barrier(0)
    Unit cur, nxt; int ui = 0;
    if (!S.next(0, cur)) return;
    f32x4 acc[2][2][4][2];
#pragma unroll
    for (int a = 0; a < 2; ++a)
#pragma unroll
        for (int b = 0; b < 2; ++b)
#pragma unroll
            for (int m = 0; m < 4; ++m)
#pragma unroll
                for (int n = 0; n < 2; ++n) acc[a][b][m][n] = (f32x4){0.f, 0.f, 0.f, 0.f};
    bf16x8 At[4][2], B0[2][2], B1[2][2];
    const char* cA = (const char*)g.A + (size_t)cur.pm * tstep; const char* cB = (const char*)g.Bt + (size_t)cur.pn * tstep;
    S.a_ready(cur);
    if constexpr (SP2) {
        PG8_STAGE(PG8_SB(0, 0), cB, voffB); PG8_STAGE(PG8_SB(0, 1), cB + hstep, voffB); PG8_STAGE(PG8_SA(0, 0), cA, voffA); PG8_STAGE(PG8_SA(0, 1), cA + hstep, voffA);
        if (wr == 1) PG8_BAR;
        PG8_WAIT_V(2); PG8_BAR;
        PG8_STAGE(PG8_SB(1, 0), cB + kstep, voffB); PG8_STAGE(PG8_SA(1, 0), cA + kstep, voffA); PG8_STAGE(PG8_SB(1, 1), cB + hstep + kstep, voffB);
        PG8_WAIT_V(6); PG8_BAR;
    } else {
        PG8_STAGE(PG8_SB(0, 0), cB, voffB); PG8_STAGE(PG8_SA(0, 0), cA, voffA); PG8_STAGE(PG8_SB(0, 1), cB + hstep, voffB); PG8_STAGE(PG8_SA(0, 1), cA + hstep, voffA);
        if (wr == 1) PG8_BAR;
        PG8_WAIT_V(4); PG8_BAR;
        PG8_STAGE(PG8_SB(1, 0), cB + kstep, voffB); PG8_STAGE(PG8_SA(1, 0), cA + kstep, voffA); PG8_STAGE(PG8_SB(1, 1), cB + hstep + kstep, voffB);
        PG8_WAIT_V(6); PG8_BAR;
    }
    for (;;) {
        const bool has_next = S.next(ui + 1, nxt);
        const char* nA = has_next ? (const char*)g.A + (size_t)nxt.pm * tstep : cA; const char* nB = has_next ? (const char*)g.Bt + (size_t)nxt.pn * tstep : cB;
        for (int t = 0; t < nt; t += 2) {
            const bool last = (t == nt - 2);
            const char* a1 = cA + (size_t)(t + 1) * kstep;
            const char* a2 = last ? nA : cA + (size_t)(t + 2) * kstep; const char* b2 = last ? nB : cB + (size_t)(t + 2) * kstep;
            const char* a3 = a2 + kstep; const char* b3 = b2 + kstep;
            if (last && has_next) S.a_ready(nxt);
            if constexpr (SP2) {
            PG8_LDB(B0, 0, 0); PG8_LDB(B1, 0, 1); PG8_SCHED; PG8_LDA(At, 0, 0); PG8_STAGE(PG8_SA(1, 1), a1 + hstep, voffA);
            PG8_WAIT_V(8); PG8_WAIT_L(0); PG8_BAR; PG8_MMA(0, 0, At, B0); PG8_MMA(0, 1, At, B1); PG8_BAR; PG8_SCHED;
            PG8_LDA(At, 0, 1); PG8_STAGE(PG8_SB(0, 0), b2, voffB); PG8_STAGE(PG8_SB(0, 1), b2 + hstep, voffB); PG8_STAGE(PG8_SA(0, 0), a2, voffA);
            PG8_WAIT_V(8); PG8_WAIT_L(0); PG8_BAR; PG8_MMA(1, 0, At, B0); PG8_MMA(1, 1, At, B1); PG8_BAR; PG8_SCHED;
            PG8_LDB(B0, 1, 0); PG8_LDB(B1, 1, 1); PG8_SCHED; PG8_LDA(At, 1, 0); PG8_STAGE(PG8_SA(0, 1), a2 + hstep, voffA);
            PG8_WAIT_V(8); PG8_WAIT_L(0); PG8_BAR; PG8_MMA(0, 0, At, B0); PG8_MMA(0, 1, At, B1); PG8_BAR; PG8_SCHED;
            PG8_LDA(At, 1, 1); PG8_STAGE(PG8_SB(1, 0), b3, voffB); PG8_STAGE(PG8_SB(1, 1), b3 + hstep, voffB); PG8_STAGE(PG8_SA(1, 0), a3, voffA);
            PG8_WAIT_V(8); PG8_WAIT_L(0); PG8_BAR; PG8_MMA(1, 0, At, B0); PG8_MMA(1, 1, At, B1); PG8_BAR; PG8_SCHED;
            } else {
            PG8_LDB(B0, 0, 0); PG8_SCHED; PG8_LDA(At, 0, 0); PG8_STAGE(PG8_SA(1, 1), a1 + hstep, voffA);
            PG8_WAIT_L(8); PG8_BAR; PG8_WAIT_L(0); PG8_MMA(0, 0, At, B0); PG8_BAR; PG8_SCHED;
            PG8_LDB(B1, 0, 1); PG8_STAGE(PG8_SB(0, 0), b2, voffB);
            PG8_BAR; PG8_WAIT_L(0); PG8_MMA(0, 1, At, B1); PG8_BAR;
            PG8_LDA(At, 0, 1); PG8_STAGE(PG8_SA(0, 0), a2, voffA);
            PG8_BAR; PG8_WAIT_L(0); PG8_MMA(1, 0, At, B0); PG8_BAR; PG8_SCHED;
            PG8_STAGE(PG8_SB(0, 1), b2 + hstep, voffB);
            PG8_WAIT_V(6); PG8_BAR; PG8_MMA(1, 1, At, B1); PG8_BAR;
            PG8_LDB(B0, 1, 0); PG8_SCHED; PG8_LDA(At, 1, 0); PG8_STAGE(PG8_SA(0, 1), a2 + hstep, voffA);
            PG8_WAIT_L(8); PG8_BAR; PG8_WAIT_L(0); PG8_MMA(0, 0, At, B0); PG8_BAR; PG8_SCHED;
            PG8_LDB(B1, 1, 1); PG8_STAGE(PG8_SB(1, 0), b3, voffB);
            PG8_BAR; PG8_WAIT_L(0); PG8_MMA(0, 1, At, B1); PG8_BAR;
            PG8_LDA(At, 1, 1); PG8_STAGE(PG8_SA(1, 0), a3, voffA);
            PG8_BAR; PG8_WAIT_L(0); PG8_MMA(1, 0, At, B0); PG8_BAR; PG8_SCHED;
            PG8_STAGE(PG8_SB(1, 1), b3 + hstep, voffB);
            PG8_WAIT_V(6); PG8_BAR; PG8_MMA(1, 1, At, B1); PG8_BAR;
            }
        }
        if constexpr (ALIGN_EPI) { if (wr == 0) PG8_BAR; }
        if constexpr (!Epi::AFTER_DRAIN) { E(acc, cur, wr, wc, fr, fq); S.done(cur); }
        if (!has_next) break;
#pragma unroll
        for (int a = 0; a < 2; ++a)
#pragma unroll
            for (int b = 0; b < 2; ++b)
#pragma unroll
                for (int m = 0; m < 4; ++m)
#pragma unroll
                    for (int n = 0; n < 2; ++n) acc[a][b][m][n] = (f32x4){0.f, 0.f, 0.f, 0.f};
        cur = nxt; cA = nA; cB = nB; ++ui;
        if constexpr (ALIGN_EPI) { if (wr == 1) PG8_BAR; }
    }
    PG8_WAIT_V(0);
    if constexpr (!ALIGN_EPI) { if (wr == 0) PG8_BAR; }
    PG8_BAR;
    if constexpr (Epi::AFTER_DRAIN) { E.fused(acc, cur, wr, wc, fr, fq, lds, wid, lane); S.done(cur); }
#undef PG8_SA
#undef PG8_SB
#undef PG8_STAGE
#undef PG8_LDA
#undef PG8_LDB
#undef PG8_MMA
#undef PG8_WAIT_V
#undef PG8_WAIT_L
#undef PG8_BAR
#undef PG8_SCHED
}
}
#define LAS __attribute__((address_space(3)))
typedef unsigned short bf16_t;
typedef short bf16x8 __attribute__((ext_vector_type(8)));
typedef float f32x4 __attribute__((ext_vector_type(4)));
typedef float f32x16 __attribute__((ext_vector_type(16)));
typedef unsigned u32x4 __attribute__((ext_vector_type(4)));
typedef unsigned u32x2 __attribute__((ext_vector_type(2)));
constexpr int DM = 1024, NBATCH = 16, SEQ = 2048, MF = NBATCH * SEQ;
constexpr int HM = MF;
constexpr int KM = MF;
constexpr int VP = MF + 64;
constexpr size_t BUF_ELEMS = (size_t)33792 * 1024;
constexpr int PADR = 48, NMETA = 16;
constexpr float EPS = 1e-6f;
constexpr float QSCALE = 0.125f * 1.4426950408889634f;
constexpr size_t MiB = 1u << 20;
constexpr size_t WS_WAIN = 0, WS_WAOUT = 16 * MiB, WS_WKQZ = 20 * MiB, WS_WVT = 26 * MiB, WS_WQZ1 = 28 * MiB, WS_WBOUT = 32 * MiB, WS_SS = 36 * MiB, WS_CTL = 39 * MiB,
                 WS_HB = 40 * MiB, WS_BUF0 = 106 * MiB, WS_BUF1 = 172 * MiB, WS_BUF2 = 238 * MiB, WS_BUF3 = 304 * MiB, WS_BUF4 = 370 * MiB, WS_END = 436 * MiB;
constexpr int LDS_BYTES = 135168;

using pg8::cvt_pk_bf16;
__device__ __forceinline__ float bf_lo(unsigned w) { return __uint_as_float(w << 16); }
__device__ __forceinline__ float bf_hi(unsigned w) { return __uint_as_float(w & 0xffff0000u); }
__device__ __forceinline__ float fast_exp2(float x) { return __builtin_amdgcn_exp2f(x); }
__device__ __forceinline__ float silu_f(float z) { return z * __builtin_amdgcn_rcpf(1.0f + fast_exp2(-1.4426950408889634f * z)); }
__device__ __forceinline__ float wave_sum(float v) {
#pragma unroll
    for (int o = 1; o < 64; o <<= 1) v += __shfl_xor(v, o);
    return v;
}
__device__ __forceinline__ float row_rstd(const float* part, int row, int fq) {
    const f32x4 p = *(const f32x4*)(part + (size_t)row * 16 + 4 * fq);
    float s = (p[0] + p[1]) + (p[2] + p[3]);
    s += __shfl_xor(s, 16); s += __shfl_xor(s, 32);
    return rsqrtf(s * (1.0f / DM) + EPS);
}

__device__ __forceinline__ f32x4 rstd_load(const float* part, int row, int fq) { return *(const f32x4*)(part + (size_t)row * 16 + 4 * fq); }
__device__ __forceinline__ float rstd_reduce(const f32x4 p) {
    float s = (p[0] + p[1]) + (p[2] + p[3]);
    s += __shfl_xor(s, 16); s += __shfl_xor(s, 32);
    return rsqrtf(s * (1.0f / DM) + EPS);
}
__device__ __forceinline__ float dpp_ror1(float x) { return __int_as_float(__builtin_amdgcn_update_dpp(0, __float_as_int(x), 0x121, 0xF, 0xF, false)); }
__device__ __forceinline__ float dpp_ror2(float x) { return __int_as_float(__builtin_amdgcn_update_dpp(0, __float_as_int(x), 0x122, 0xF, 0xF, false)); }
__device__ __forceinline__ float dpp_shr1(float old, float x) { return __int_as_float(__builtin_amdgcn_update_dpp(__float_as_int(old), __float_as_int(x), 0x111, 0xF, 0xF, false)); }
__device__ __forceinline__ float dpp_shr2(float old, float x) { return __int_as_float(__builtin_amdgcn_update_dpp(__float_as_int(old), __float_as_int(x), 0x112, 0xF, 0xF, false)); }
struct EpiAIn {
    static constexpr bool PERM = false, AFTER_DRAIN = false;
    const float* part; bf16_t* vbuf; bf16_t* gzbuf; bf16_t* ybuf; const float* cw; const float* cb;
    __device__ __forceinline__ void operator()(const f32x4 (&acc)[2][2][4][2], const pg8::Unit& u, int wr, int wc, int fr, int fq) const {
        const int ch0 = 64 * u.pn + 16 * wc + 4 * fq;
        const f32x4 w0 = *(const f32x4*)(cw + ch0), w1 = *(const f32x4*)(cw + DM + ch0), w2 = *(const f32x4*)(cw + 2 * DM + ch0), bb = *(const f32x4*)(cb + ch0);
        f32x4 pp[2][4];
#pragma unroll
        for (int ai = 0; ai < 2; ++ai)
#pragma unroll
            for (int m = 0; m < 4; ++m) pp[ai][m] = rstd_load(part, u.pm * 256 + ai * 128 + wr * 64 + m * 16 + fr, fq);
#pragma unroll
        for (int ai = 0; ai < 2; ++ai) {
            f32x4 vprev = (f32x4){0.f, 0.f, 0.f, 0.f};
#pragma unroll
            for (int m = 0; m < 4; ++m) {
                const int row = u.pm * 256 + ai * 128 + wr * 64 + m * 16 + fr;
                const float rs = rstd_reduce(pp[ai][m]);
                const f32x4 b = acc[ai][0][m][0] * rs, c = acc[ai][0][m][1] * rs, hin = acc[ai][1][m][0] * rs, z = acc[ai][1][m][1] * rs;
                const f32x4 v = c * hin;
                f32x4 gz, y;
#pragma unroll
                for (int j = 0; j < 4; ++j) {
                    gz[j] = b[j] * silu_f(z[j]);
                    const float p1 = dpp_shr1(dpp_ror1(vprev[j]), v[j]), p2 = dpp_shr2(dpp_ror2(vprev[j]), v[j]);
                    y[j] = gz[j] * (w0[j] * p2 + w1[j] * p1 + w2[j] * v[j] + bb[j]);
                }
                const size_t o = (size_t)row * DM + ch0;
                if (m == 0 && fr < 2) {
                    u32x2 wv, wg; wv.x = cvt_pk_bf16(v[0], v[1]); wv.y = cvt_pk_bf16(v[2], v[3]); wg.x = cvt_pk_bf16(gz[0], gz[1]); wg.y = cvt_pk_bf16(gz[2], gz[3]);
                    *(u32x2*)(vbuf + o) = wv; *(u32x2*)(gzbuf + o) = wg;
                } else {
                    u32x2 wy; wy.x = cvt_pk_bf16(y[0], y[1]); wy.y = cvt_pk_bf16(y[2], y[3]);
                    *(u32x2*)(ybuf + o) = wy;
                    if (m == 3 && fr >= 14) { u32x2 wv; wv.x = cvt_pk_bf16(v[0], v[1]); wv.y = cvt_pk_bf16(v[2], v[3]); *(u32x2*)(vbuf + o) = wv; }
                }
                vprev = v;
            }
        }
    }
};
struct EpiRes {
    static constexpr bool PERM = true, AFTER_DRAIN = false;
    bf16_t* hb; float* part;
    __device__ __forceinline__ void operator()(const f32x4 (&acc)[2][2][4][2], const pg8::Unit& u, int wr, int wc, int fr, int fq) const {
        u32x4 old[2][4][2];
#pragma unroll
        for (int ai = 0; ai < 2; ++ai)
#pragma unroll
            for (int m = 0; m < 4; ++m)
#pragma unroll
                for (int bj = 0; bj < 2; ++bj)
                    old[ai][m][bj] = *(const u32x4*)(hb + (size_t)(u.pm * 256 + ai * 128 + wr * 64 + m * 16 + fr) * DM + u.pn * 256 + bj * 128 + wc * 32 + 8 * fq);
#pragma unroll
        for (int ai = 0; ai < 2; ++ai)
#pragma unroll
            for (int m = 0; m < 4; ++m) {
                const int row = u.pm * 256 + ai * 128 + wr * 64 + m * 16 + fr;
                float ssq = 0.f;
#pragma unroll
                for (int bj = 0; bj < 2; ++bj) {
                    bf16_t* p = hb + (size_t)row * DM + u.pn * 256 + bj * 128 + wc * 32 + 8 * fq;
                    const u32x4 o4 = old[ai][m][bj];
                    const f32x4 a0 = acc[ai][bj][m][0], a1 = acc[ai][bj][m][1];
                    float v[8];
                    v[0] = bf_lo(o4.x) + a0[0]; v[1] = bf_hi(o4.x) + a0[1]; v[2] = bf_lo(o4.y) + a0[2]; v[3] = bf_hi(o4.y) + a0[3];
                    v[4] = bf_lo(o4.z) + a1[0]; v[5] = bf_hi(o4.z) + a1[1]; v[6] = bf_lo(o4.w) + a1[2]; v[7] = bf_hi(o4.w) + a1[3];
#pragma unroll
                    for (int i = 0; i < 8; ++i) ssq += v[i] * v[i];
                    u32x4 w; w.x = cvt_pk_bf16(v[0], v[1]); w.y = cvt_pk_bf16(v[2], v[3]); w.z = cvt_pk_bf16(v[4], v[5]); w.w = cvt_pk_bf16(v[6], v[7]);
                    *(u32x4*)p = w;
                }
                ssq += __shfl_xor(ssq, 16); ssq += __shfl_xor(ssq, 32);
                if (fq == 0) part[(size_t)row * 16 + 4 * u.pn + wc] = ssq;
            }
    }
};
struct EpiKQZ {
    static constexpr bool PERM = true, AFTER_DRAIN = false;
    const float* part; bf16_t* kqz; int tbase;
    __device__ __forceinline__ void operator()(const f32x4 (&acc)[2][2][4][2], const pg8::Unit& u, int wr, int wc, int fr, int fq) const {
        const int t = (u.pn >> 2) + tbase;
        bf16_t* dst = kqz + (size_t)t * BUF_ELEMS;
        const float sc = (t == 1) ? QSCALE : 1.0f;
        const int col0 = (u.pn & 3) * 256 + wc * 32 + 8 * fq;
        f32x4 pp[2][4];
#pragma unroll
        for (int ai = 0; ai < 2; ++ai)
#pragma unroll
            for (int m = 0; m < 4; ++m) pp[ai][m] = rstd_load(part, u.pm * 256 + ai * 128 + wr * 64 + m * 16 + fr, fq);
#pragma unroll
        for (int ai = 0; ai < 2; ++ai)
#pragma unroll
            for (int m = 0; m < 4; ++m) {
                const int row = u.pm * 256 + ai * 128 + wr * 64 + m * 16 + fr;
                const float rs = rstd_reduce(pp[ai][m]) * sc;
#pragma unroll
                for (int bj = 0; bj < 2; ++bj) {
                    f32x4 a0 = acc[ai][bj][m][0] * rs, a1 = acc[ai][bj][m][1] * rs;
                    if (t == 2) {
#pragma unroll
                        for (int j = 0; j < 4; ++j) { a0[j] = silu_f(a0[j]); a1[j] = silu_f(a1[j]); }
                    }
                    u32x4 w; w.x = cvt_pk_bf16(a0[0], a0[1]); w.y = cvt_pk_bf16(a0[2], a0[3]); w.z = cvt_pk_bf16(a1[0], a1[1]); w.w = cvt_pk_bf16(a1[2], a1[3]);
                    *(u32x4*)(dst + (size_t)row * DM + col0 + bj * 128) = w;
                }
            }
    }
};
struct EpiVt {
    static constexpr bool PERM = true, AFTER_DRAIN = false;
    const float* part; bf16_t* vt;
    __device__ __forceinline__ void operator()(const f32x4 (&acc)[2][2][4][2], const pg8::Unit& u, int wr, int wc, int fr, int fq) const {
        const int lane = fr + 16 * fq;
        float rsl;
        { const int tok = u.pn * 256 + 128 * (lane >> 5) + 32 * wc + (lane & 31);
          const f32x4* p = (const f32x4*)(part + (size_t)tok * 16);
          const f32x4 p0 = p[0], p1 = p[1], p2 = p[2], p3 = p[3];
          const float s = ((p0[0] + p0[1]) + (p0[2] + p0[3])) + ((p1[0] + p1[1]) + (p1[2] + p1[3])) + ((p2[0] + p2[1]) + (p2[2] + p2[3])) + ((p3[0] + p3[1]) + (p3[2] + p3[3]));
          rsl = rsqrtf(s * (1.0f / DM) + EPS); }
        float rs[2][8];
#pragma unroll
        for (int bj = 0; bj < 2; ++bj)
#pragma unroll
            for (int i = 0; i < 8; ++i) rs[bj][i] = __shfl(rsl, 32 * bj + 8 * fq + i);
#pragma unroll
        for (int ai = 0; ai < 2; ++ai)
#pragma unroll
            for (int m = 0; m < 4; ++m) {
                const int e = u.pm * 256 + ai * 128 + wr * 64 + m * 16 + fr;
#pragma unroll
                for (int bj = 0; bj < 2; ++bj)
#pragma unroll
                    for (int n = 0; n < 2; ++n) {
                        const f32x4 a = acc[ai][bj][m][n];
                        u32x2 w; w.x = cvt_pk_bf16(a[0] * rs[bj][4 * n + 0], a[1] * rs[bj][4 * n + 1]); w.y = cvt_pk_bf16(a[2] * rs[bj][4 * n + 2], a[3] * rs[bj][4 * n + 3]);
                        *(u32x2*)(vt + (size_t)e * VP + u.pn * 256 + bj * 128 + wc * 32 + 16 * (fq >> 1) + 8 * n + 4 * (fq & 1)) = w;
                    }
            }
    }
};

__device__ __forceinline__ void mini_gemm4(const bf16_t* __restrict__ A, const bf16_t* __restrict__ w0, const bf16_t* __restrict__ w1, const bf16_t* __restrict__ w2, const bf16_t* __restrict__ w3, f32x4 (&acc)[4], int wave, int lane, LAS unsigned char* lds) {
    const int off = (lane & 15) * DM + (lane >> 4) * 8 + wave * 128;
    const bf16_t* ap = A + off; const bf16_t* p0 = w0 + off; const bf16_t* p1 = w1 + off; const bf16_t* p2 = w2 + off; const bf16_t* p3 = w3 + off;
    bf16x8 bv[4], a0[4], a1[4], a2[4], a3[4];
#pragma unroll
    for (int kk = 0; kk < 4; ++kk) { bv[kk] = *(const bf16x8*)(ap + kk * 32); a0[kk] = *(const bf16x8*)(p0 + kk * 32); a1[kk] = *(const bf16x8*)(p1 + kk * 32); a2[kk] = *(const bf16x8*)(p2 + kk * 32); a3[kk] = *(const bf16x8*)(p3 + kk * 32); }
#pragma unroll
    for (int i = 0; i < 4; ++i) acc[i] = (f32x4){0.f, 0.f, 0.f, 0.f};
#pragma unroll
    for (int kk = 0; kk < 4; ++kk) {
        acc[0] = __builtin_amdgcn_mfma_f32_16x16x32_bf16(a0[kk], bv[kk], acc[0], 0, 0, 0); acc[1] = __builtin_amdgcn_mfma_f32_16x16x32_bf16(a1[kk], bv[kk], acc[1], 0, 0, 0);
        acc[2] = __builtin_amdgcn_mfma_f32_16x16x32_bf16(a2[kk], bv[kk], acc[2], 0, 0, 0); acc[3] = __builtin_amdgcn_mfma_f32_16x16x32_bf16(a3[kk], bv[kk], acc[3], 0, 0, 0);
    }
    LAS f32x4* red = (LAS f32x4*)lds;
#pragma unroll
    for (int i = 0; i < 4; ++i) red[(wave * 4 + i) * 64 + lane] = acc[i];
    __syncthreads();
    if (wave == 0) {
#pragma unroll
        for (int w = 1; w < 8; ++w)
#pragma unroll
            for (int i = 0; i < 4; ++i) acc[i] += red[(w * 4 + i) * 64 + lane];
    }
    __syncthreads();
}
__device__ __forceinline__ float meta_rstd(const float* part, int m) {
    const f32x4* p = (const f32x4*)(part + (size_t)(HM + m) * 16);
    const f32x4 p0 = p[0], p1 = p[1], p2 = p[2], p3 = p[3];
    const float s = ((p0[0] + p0[1]) + (p0[2] + p0[3])) + ((p1[0] + p1[1]) + (p1[2] + p1[3])) + ((p2[0] + p2[1]) + (p2[2] + p2[3])) + ((p3[0] + p3[1]) + (p3[2] + p3[3]));
    return rsqrtf(s * (1.0f / DM) + EPS);
}
__device__ __forceinline__ void meta_ain_job(int j, const bf16_t* hb, const bf16_t* W, const float* part, bf16_t* vbuf, bf16_t* gzbuf, int wave, int lane, LAS unsigned char* lds) {
    const int pn = j >> 2, wc = j & 3, fr = lane & 15, fq = lane >> 4;
    const bf16_t* wb = W + (size_t)(256 * pn + 32 * wc) * DM;
    f32x4 acc[4];
    mini_gemm4(hb + (size_t)HM * DM, wb, wb + 16 * DM, wb + 128 * DM, wb + 144 * DM, acc, wave, lane, lds);
    if (wave != 0) return;
    const float rs = meta_rstd(part, fr);
    const f32x4 bb = acc[0] * rs, c = acc[1] * rs, hin = acc[2] * rs, z = acc[3] * rs;
    const f32x4 v = c * hin; f32x4 gz;
#pragma unroll
    for (int q = 0; q < 4; ++q) gz[q] = bb[q] * silu_f(z[q]);
    u32x2 wv, wg; wv.x = cvt_pk_bf16(v[0], v[1]); wv.y = cvt_pk_bf16(v[2], v[3]); wg.x = cvt_pk_bf16(gz[0], gz[1]); wg.y = cvt_pk_bf16(gz[2], gz[3]);
    const size_t o = (size_t)(HM + fr) * DM + 64 * pn + 16 * wc + 4 * fq;
    *(u32x2*)(vbuf + o) = wv; *(u32x2*)(gzbuf + o) = wg;
}
__device__ __forceinline__ void meta_res_job(int j, const bf16_t* A, const bf16_t* W, bf16_t* hb, float* part, int wave, int lane, LAS unsigned char* lds) {
    const int fr = lane & 15, fq = lane >> 4;
    const bf16_t* wb = W + (size_t)(64 * j) * DM;
    f32x4 acc[4];
    mini_gemm4(A + (size_t)HM * DM, wb, wb + 16 * DM, wb + 32 * DM, wb + 48 * DM, acc, wave, lane, lds);
    if (wave != 0) return;
    float ssq = 0.f;
#pragma unroll
    for (int i = 0; i < 4; ++i) {
        bf16_t* p = hb + (size_t)(HM + fr) * DM + 64 * j + 16 * i + 4 * fq;
        const u32x2 old = *(const u32x2*)p;
        const float v0 = bf_lo(old.x) + acc[i][0], v1 = bf_hi(old.x) + acc[i][1], v2 = bf_lo(old.y) + acc[i][2], v3 = bf_hi(old.y) + acc[i][3];
        ssq += (v0 * v0 + v1 * v1) + (v2 * v2 + v3 * v3);
        u32x2 w; w.x = cvt_pk_bf16(v0, v1); w.y = cvt_pk_bf16(v2, v3); *(u32x2*)p = w;
    }
    ssq += __shfl_xor(ssq, 16); ssq += __shfl_xor(ssq, 32);
    if (fq == 0) part[(size_t)(HM + fr) * 16 + j] = ssq;
}
__device__ __forceinline__ void meta_k_job(int j, const bf16_t* hb, const bf16_t* W, const float* part, bf16_t* kb, int wave, int lane, LAS unsigned char* lds) {
    const int fr = lane & 15, fq = lane >> 4;
    const bf16_t* wb = W + (size_t)(64 * j) * DM;
    f32x4 acc[4];
    mini_gemm4(hb + (size_t)HM * DM, wb, wb + 16 * DM, wb + 32 * DM, wb + 48 * DM, acc, wave, lane, lds);
    if (wave != 0) return;
    const float rs = meta_rstd(part, fr);
#pragma unroll
    for (int i = 0; i < 4; ++i) { const f32x4 a = acc[i] * rs; u32x2 w; w.x = cvt_pk_bf16(a[0], a[1]); w.y = cvt_pk_bf16(a[2], a[3]);
        *(u32x2*)(kb + (size_t)(KM + PADR + fr) * DM + 64 * j + 16 * i + 4 * fq) = w; }
}
__device__ __forceinline__ void meta_v_job(int j, const bf16_t* hb, const bf16_t* Wv, const float* part, bf16_t* vt, int wave, int lane, LAS unsigned char* lds) {
    const int fr = lane & 15, fq = lane >> 4;
    const bf16_t* wb = Wv + (size_t)(64 * j) * DM;
    f32x4 acc[4];
    mini_gemm4(hb + (size_t)HM * DM, wb, wb + 16 * DM, wb + 32 * DM, wb + 48 * DM, acc, wave, lane, lds);
    if (wave != 0) return;
    const float rs = meta_rstd(part, fr);
    const int pos = 8 * ((fr >> 2) & 1) + 4 * (fr >> 3) + (fr & 3);
#pragma unroll
    for (int i = 0; i < 4; ++i)
#pragma unroll
        for (int r = 0; r < 4; ++r) { const int e = 64 * j + 16 * i + 4 * fq + r; vt[(size_t)e * VP + MF + PADR + pos] = (bf16_t)(cvt_pk_bf16(acc[i][r] * rs, 0.f) & 0xffffu); }
}
#define XB_TMO      128
#define XB_XCNT(j)  (256  + 64 * (j))
#define XB_XSUB(j)  (1280 + 64 * (j))
#define XB_XGEN(j)  (2304 + 64 * (j))
#define XB_TOP      3328
#define XB_TOPGEN   3392
#define XCD_BAR_WORDS 3456
#define XB_SPIN_CAP (1u << 18)

__device__ __forceinline__ unsigned xb_ld(unsigned* p)              { return __hip_atomic_load(p, __ATOMIC_RELAXED, __HIP_MEMORY_SCOPE_AGENT); }
__device__ __forceinline__ unsigned xb_add(unsigned* p, unsigned v) { return __hip_atomic_fetch_add(p, v, __ATOMIC_RELAXED, __HIP_MEMORY_SCOPE_AGENT); }
__device__ __forceinline__ unsigned xb_xcc_id() { return (unsigned)__builtin_amdgcn_s_getreg((3 << 11) | 20) & 0xFu; }
#define XB_SPIN(cond, bar) do { unsigned _sp = 0; while (cond) { __builtin_amdgcn_s_sleep(1); \
    if ((++_sp & 255u) == 0u) { if (xb_ld(&(bar)[XB_TMO])) break; if (_sp > XB_SPIN_CAP) { atomicAdd(&(bar)[XB_TMO], 1u); break; } } } } while (0)

struct XcdBarrier {
    unsigned* bar; unsigned x;
    volatile LAS unsigned* st;
};

__device__ __forceinline__ XcdBarrier xcd_barrier_post(unsigned* bar, volatile LAS unsigned* st) {
    XcdBarrier b; b.bar = bar; b.x = xb_xcc_id(); b.st = st;
    if (threadIdx.x == 0) (void)xb_add(&bar[XB_XCNT(b.x)], 1u);
    return b;
}
__device__ __forceinline__ void xcd_barrier_complete(unsigned* bar, unsigned x, unsigned& nloc, unsigned& nx) {
    const unsigned G = gridDim.x * gridDim.y * gridDim.z;
    unsigned sum, cnt, mine, sp = 0u;
    for (;;) {
        sum = 0u; cnt = 0u; mine = 0u;
#pragma unroll
        for (unsigned j = 0; j < 16; ++j) { const unsigned c = xb_ld(&bar[XB_XCNT(j)]); sum += c; cnt += (c > 0u) ? 1u : 0u; mine = (j == x) ? c : mine; }
        if (sum == G) break;
        __builtin_amdgcn_s_sleep(1);
        if ((++sp & 255u) == 0u) { if (xb_ld(&bar[XB_TMO])) break; if (sp > XB_SPIN_CAP) { atomicAdd(&bar[XB_TMO], 1u); break; } }
    }
    nloc = mine > 0u ? mine : 1u; nx = cnt > 0u ? cnt : 1u;
}

__device__ __forceinline__ void xcd_barrier(const XcdBarrier& b) {
    asm volatile("s_waitcnt vmcnt(0)" ::: "memory");
    __syncthreads();
    if (threadIdx.x == 0) {
        unsigned* bar = b.bar;
        __builtin_amdgcn_s_waitcnt(0);
        unsigned nloc = b.st[0], nx = b.st[1];
        if (nloc == 0u) { xcd_barrier_complete(bar, b.x, nloc, nx); b.st[0] = nloc; b.st[1] = nx; }
        const unsigned old = xb_add(&bar[XB_XSUB(b.x)], 1u);
        const unsigned gen = old / nloc;
        if (old + 1u == (gen + 1u) * nloc) {
            __builtin_amdgcn_fence(__ATOMIC_RELEASE, "agent");
            asm volatile("s_waitcnt vmcnt(0)" ::: "memory");
            const unsigned og = xb_add(&bar[XB_TOP], 1u);
            const unsigned tg = og / nx;
            if (og + 1u == (tg + 1u) * nx) xb_add(&bar[XB_TOPGEN], 1u);
            else XB_SPIN(xb_ld(&bar[XB_TOPGEN]) == tg, bar);
            __builtin_amdgcn_fence(__ATOMIC_ACQUIRE, "agent");
            xb_add(&bar[XB_XGEN(b.x)], 1u);
            asm volatile("s_waitcnt vmcnt(0)" ::: "memory");
        } else {
            XB_SPIN(xb_ld(&bar[XB_XGEN(b.x)]) == gen, bar);
            __builtin_amdgcn_fence(__ATOMIC_ACQUIRE, "agent");
            asm volatile("s_waitcnt vmcnt(0)" ::: "memory");
        }
    }
    __syncthreads();
}
__device__ __forceinline__ int crow(int r, int hi) { return (r & 3) + 8 * (r >> 2) + 4 * hi; }
#define ATT_BAR() asm volatile("s_waitcnt lgkmcnt(0)\n\ts_barrier" ::: "memory")
__device__ __forceinline__ void att_wait_vm(int n) {
    if (n >= 8) asm volatile("s_waitcnt vmcnt(8)" ::: "memory"); else if (n == 6) asm volatile("s_waitcnt vmcnt(6)" ::: "memory");
    else if (n == 4) asm volatile("s_waitcnt vmcnt(4)" ::: "memory"); else if (n == 2) asm volatile("s_waitcnt vmcnt(2)" ::: "memory"); else asm volatile("s_waitcnt vmcnt(0)" ::: "memory");
}
constexpr float ATT_THR = 12.0f;
constexpr int ATT_VRING = 65536, ATT_XSTRIDE = 17408;
__device__ __forceinline__ void attn_unit(LAS unsigned char* lds, const bf16_t* Qb, const bf16_t* __restrict__ Kb, const bf16_t* __restrict__ Vt, const bf16_t* __restrict__ Zs,
                                          bf16_t* Ob  , const float* __restrict__ subg, float lam, float oml, int b, int h, int j) {
    int tid = threadIdx.x; asm volatile("" : "+v"(tid));
    const int lane = tid & 63, wid = __builtin_amdgcn_readfirstlane(tid >> 6), sub = wid & 3, map = wid >> 2, r32 = lane & 31, hi = lane >> 5;
    const size_t rowbase = (size_t)b * SEQ, qbase = rowbase + 128 * j;
    const int NT = 2 * j + 3, tmax = 2 * j + 1 + (sub >> 1);
    const bool active = true;
    bf16x8 qf[4];
    { const bf16_t* qsrc = Qb + (qbase + 32 * sub + r32) * DM + h * 128 + map * 64 + hi * 8;
#pragma unroll
      for (int ks = 0; ks < 4; ++ks) qf[ks] = __builtin_nontemporal_load((const bf16x8*)(qsrc + 16 * ks)); }
    const int prow = lane >> 3, pc = lane & 7;
    const int krow = 8 * wid + prow;
    const unsigned koff = (unsigned)(krow * DM + ((pc ^ ((krow >> 1) & 7)) << 3)) * 2u;
    const int vrow0 = 16 * wid + prow, vrow1 = vrow0 + 8;
    const unsigned voff0 = (unsigned)(vrow0 * VP + ((pc ^ ((vrow0 >> 1) & 7)) << 3)) * 2u, voff1 = (unsigned)(vrow1 * VP + ((pc ^ ((vrow1 >> 1) & 7)) << 3)) * 2u;
    const char* kbase = (const char*)(Kb + h * 128);
    const char* vbase = (const char*)(Vt + (size_t)(h * 128) * VP);
#define DMA16(g, off) __builtin_amdgcn_global_load_lds((const unsigned*)(g), (LAS unsigned*)(lds + (off)), 16, 0, 0)
#define TILE_ROW0(t) ((t) == 0 ? (size_t)KM : rowbase + (size_t)((t) - 1) * 64)
#define DMA_K(t, slot) do { const char* kb_ = kbase + TILE_ROW0(t) * (DM * 2); DMA16(kb_ + koff, (slot) * 16384 + wid * 1024); DMA16(kb_ + 128 + koff, (slot) * 16384 + 8192 + wid * 1024); } while (0)
#define DMA_V(t, slot) do { const char* vb_ = vbase + TILE_ROW0(t) * 2; DMA16(vb_ + voff0, ATT_VRING + (slot) * 16384 + wid * 2048); DMA16(vb_ + voff1, ATT_VRING + (slot) * 16384 + wid * 2048 + 1024); } while (0)
    DMA_K(0, 0); DMA_V(0, 0); DMA_K(1, 1);
    const unsigned offk0 = (unsigned)(r32 * 128 + ((hi ^ ((r32 >> 1) & 7)) << 4));
#define OFFK(ks) (offk0 ^ (32u * (ks)))
    f32x16 o[4], s0, s1, negm;
#pragma unroll
    for (int r = 0; r < 16; ++r) { o[0][r] = 0.f; o[1][r] = 0.f; o[2][r] = 0.f; o[3][r] = 0.f; negm[r] = 0.f; }
    float mref = 0.f, lrun = 0.f;
    bf16x8 pf[4];
#define RD128(dst, addr, imm) asm volatile("ds_read_b128 %0, %1 offset:%c2" : "=&v"(dst) : "v"(addr), "i"(imm) : "memory")
#define LW4(n, X) asm volatile("s_waitcnt lgkmcnt(" #n ")" : "+v"(X[0]), "+v"(X[1]), "+v"(X[2]), "+v"(X[3]) :: "memory")
#define SB() __builtin_amdgcn_sched_barrier(0)
#define MF(a, b, c) __builtin_amdgcn_mfma_f32_32x32x16_bf16(a, b, c, 0, 0, 0)
    const unsigned ldsb = (unsigned)(uintptr_t)lds;
    bf16x8 gA[4], gB[4], gC[4];
#define RDV(G, va) do { RD128(G[0], va, 0); RD128(G[1], va, 4096); RD128(G[2], va, 8192); RD128(G[3], va, 12288); } while (0)
#define RDK(G, ka, c0, c1) do { RD128(G[0], ka + OFFK(c0), 0); RD128(G[1], ka + OFFK(c0), 4096); RD128(G[2], ka + OFFK(c1), 0); RD128(G[3], ka + OFFK(c1), 4096); } while (0)
#define PV4(G, p) do { o[0] = MF(G[0], p, o[0]); o[1] = MF(G[1], p, o[1]); o[2] = MF(G[2], p, o[2]); o[3] = MF(G[3], p, o[3]); SB(); } while (0)
#define ATT_S0() do { const unsigned ka_ = ldsb + map * 8192; \
        RDK(gA, ka_, 0, 1); RDK(gB, ka_, 2, 3); \
        LW4(4, gA); s0 = MF(gA[0], qf[0], negm); s1 = MF(gA[1], qf[0], negm); s0 = MF(gA[2], qf[1], s0); s1 = MF(gA[3], qf[1], s1); SB(); \
        LW4(0, gB); s0 = MF(gB[0], qf[2], s0); s1 = MF(gB[1], qf[2], s1); s0 = MF(gB[2], qf[3], s0); s1 = MF(gB[3], qf[3], s1); SB(); } while (0)
#define ATT_ISSUE(vslot) do { const unsigned vb_ = ldsb + ATT_VRING + (vslot) * 16384; \
        RDV(gA, vb_ + OFFK(0)); RDV(gB, vb_ + OFFK(1)); RDV(gC, vb_ + OFFK(2)); } while (0)
#define ATT_CONSUME(vslot, kslot, DO_S) do { const unsigned vb_ = ldsb + ATT_VRING + (vslot) * 16384, ka_ = ldsb + (kslot) * 16384 + map * 8192; \
        LW4(8, gA); PV4(gA, pf[0]); RDV(gA, vb_ + OFFK(3)); \
        if (DO_S) { \
            LW4(8, gB); PV4(gB, pf[1]); RDK(gB, ka_, 0, 1); \
            LW4(8, gC); PV4(gC, pf[2]); RDK(gC, ka_, 2, 3); \
            LW4(8, gA); PV4(gA, pf[3]); \
            LW4(4, gB); s0 = MF(gB[0], qf[0], negm); s1 = MF(gB[1], qf[0], negm); s0 = MF(gB[2], qf[1], s0); s1 = MF(gB[3], qf[1], s1); SB(); \
            LW4(0, gC); s0 = MF(gC[0], qf[2], s0); s1 = MF(gC[1], qf[2], s1); s0 = MF(gC[2], qf[3], s0); s1 = MF(gC[3], qf[3], s1); SB(); \
        } else { LW4(8, gB); PV4(gB, pf[1]); LW4(4, gC); PV4(gC, pf[2]); LW4(0, gA); PV4(gA, pf[3]); } } while (0)
#define MAX3(a, b, c) ({ float r_; asm("v_max3_f32 %0, %1, %2, %3" : "=v"(r_) : "v"(a), "v"(b), "v"(c)); r_; })
#define ATT_SOFTMAX(first) do { \
        asm volatile("s_nop 15\n\ts_nop 7" : "+v"(s0), "+v"(s1));                 \
        float ma_ = MAX3(s0[0], s0[1], s0[2]), mb_ = MAX3(s0[3], s0[4], s0[5]); \
        ma_ = MAX3(ma_, s0[6], s0[7]); mb_ = MAX3(mb_, s0[8], s0[9]); ma_ = MAX3(ma_, s0[10], s0[11]); mb_ = MAX3(mb_, s0[12], s0[13]); ma_ = MAX3(ma_, s0[14], s0[15]); \
        mb_ = MAX3(mb_, s1[0], s1[1]); ma_ = MAX3(ma_, s1[2], s1[3]); mb_ = MAX3(mb_, s1[4], s1[5]); ma_ = MAX3(ma_, s1[6], s1[7]); \
        mb_ = MAX3(mb_, s1[8], s1[9]); ma_ = MAX3(ma_, s1[10], s1[11]); mb_ = MAX3(mb_, s1[12], s1[13]); ma_ = MAX3(ma_, s1[14], s1[15]); \
        float mx_ = MAX3(ma_, mb_, mb_); \
        { auto rr_ = __builtin_amdgcn_permlane32_swap(__float_as_uint(mx_), __float_as_uint(mx_), false, false); const float x0_ = __uint_as_float(rr_[0]), x1_ = __uint_as_float(rr_[1]); mx_ = MAX3(x0_, x1_, x1_); } \
        if (first) { mref = mx_; \
            _Pragma("unroll") for (int r = 0; r < 16; ++r) { s0[r] -= mx_; s1[r] -= mx_; negm[r] = -mref; } } \
        else if (__any(mx_ > ATT_THR)) { \
            const float dl_ = (mx_ > 0.f) ? mx_ : 0.f; const float al_ = fast_exp2(-dl_); mref += dl_; lrun *= al_; \
            _Pragma("unroll") for (int r = 0; r < 16; ++r) { s0[r] -= dl_; s1[r] -= dl_; negm[r] = -mref; } \
            _Pragma("unroll") for (int eb = 0; eb < 4; ++eb) _Pragma("unroll") for (int r = 0; r < 16; ++r) o[eb][r] *= al_; } \
        float ls_ = 0.f; \
        _Pragma("unroll") for (int r = 0; r < 16; ++r) { s0[r] = fast_exp2(s0[r]); s1[r] = fast_exp2(s1[r]); ls_ += s0[r] + s1[r]; } \
        lrun += ls_; \
        _Pragma("unroll") for (int s = 0; s < 2; ++s) { u32x4 w_; \
            w_.x = cvt_pk_bf16(s0[8 * s + 0], s0[8 * s + 1]); w_.y = cvt_pk_bf16(s0[8 * s + 2], s0[8 * s + 3]); w_.z = cvt_pk_bf16(s0[8 * s + 4], s0[8 * s + 5]); w_.w = cvt_pk_bf16(s0[8 * s + 6], s0[8 * s + 7]); \
            pf[s] = __builtin_bit_cast(bf16x8, w_); \
            w_.x = cvt_pk_bf16(s1[8 * s + 0], s1[8 * s + 1]); w_.y = cvt_pk_bf16(s1[8 * s + 2], s1[8 * s + 3]); w_.z = cvt_pk_bf16(s1[8 * s + 4], s1[8 * s + 5]); w_.w = cvt_pk_bf16(s1[8 * s + 6], s1[8 * s + 7]); \
            pf[2 + s] = __builtin_bit_cast(bf16x8, w_); } } while (0)
#define ADDF(a, b) ({ float r_; asm("v_add_f32 %0, %1, %2" : "=v"(r_) : "v"(a), "v"(b)); r_; })
#define SUM8(X, b) ADDF(ADDF(ADDF(X[b], X[b + 1]), ADDF(X[b + 2], X[b + 3])), ADDF(ADDF(X[b + 4], X[b + 5]), ADDF(X[b + 6], X[b + 7])))
#define MFN(d, a, b, c) asm volatile("v_mfma_f32_32x32x16_bf16 %0, %1, %2, %3" : "=&v"(d) : "v"(a), "v"(b), "v"(c))
#define EX4(X, b) do { X[b] = fast_exp2(X[b]); X[b + 1] = fast_exp2(X[b + 1]); X[b + 2] = fast_exp2(X[b + 2]); X[b + 3] = fast_exp2(X[b + 3]); } while (0)
#define CV8(dst, X, b) do { u32x4 w_; w_.x = cvt_pk_bf16(X[b], X[b + 1]); w_.y = cvt_pk_bf16(X[b + 2], X[b + 3]); w_.z = cvt_pk_bf16(X[b + 4], X[b + 5]); w_.w = cvt_pk_bf16(X[b + 6], X[b + 7]); dst = __builtin_bit_cast(bf16x8, w_); } while (0)
#define ATT_UNI(vslot, kslot) do { const unsigned vb_ = ldsb + ATT_VRING + (vslot) * 16384, ka_ = ldsb + (kslot) * 16384 + map * 8192; \
        RDK(gA, ka_, 0, 1); RDK(gB, ka_, 2, 3); RDV(gC, vb_ + OFFK(0)); \
        __builtin_amdgcn_s_setprio(2); \
        LW4(8, gA); MFN(s0, gA[0], qf[0], negm); MFN(s1, gA[1], qf[0], negm); s0 = MF(gA[2], qf[1], s0); s1 = MF(gA[3], qf[1], s1); SB(); \
        RDV(gA, vb_ + OFFK(1)); \
        LW4(8, gB); s0 = MF(gB[0], qf[2], s0); s1 = MF(gB[1], qf[2], s1); s0 = MF(gB[2], qf[3], s0); s1 = MF(gB[3], qf[3], s1); SB(); \
        RDV(gB, vb_ + OFFK(2)); \
        __builtin_amdgcn_s_setprio(0); \
        LW4(8, gC); o[0] = MF(gC[0], pf[0], o[0]); o[1] = MF(gC[1], pf[0], o[1]); SB(); \
        asm volatile("s_nop 15\n\ts_nop 7" : "+v"(s0), "+v"(s1)); \
        float ma_ = MAX3(s0[0], s0[1], s0[2]), mb_ = MAX3(s0[3], s0[4], s0[5]); ma_ = MAX3(ma_, s0[6], s0[7]); mb_ = MAX3(mb_, s0[8], s0[9]); SB(); \
        o[2] = MF(gC[2], pf[0], o[2]); SB(); \
        ma_ = MAX3(ma_, s0[10], s0[11]); mb_ = MAX3(mb_, s0[12], s0[13]); ma_ = MAX3(ma_, s0[14], s0[15]); mb_ = MAX3(mb_, s1[0], s1[1]); ma_ = MAX3(ma_, s1[2], s1[3]); mb_ = MAX3(mb_, s1[4], s1[5]); SB(); \
        o[3] = MF(gC[3], pf[0], o[3]); SB(); \
        RDV(gC, vb_ + OFFK(3)); \
        ma_ = MAX3(ma_, s1[6], s1[7]); mb_ = MAX3(mb_, s1[8], s1[9]); ma_ = MAX3(ma_, s1[10], s1[11]); mb_ = MAX3(mb_, s1[12], s1[13]); ma_ = MAX3(ma_, s1[14], s1[15]); \
        float mx_ = MAX3(ma_, mb_, mb_); \
        { auto rr_ = __builtin_amdgcn_permlane32_swap(__float_as_uint(mx_), __float_as_uint(mx_), false, false); const float x0_ = __uint_as_float(rr_[0]), x1_ = __uint_as_float(rr_[1]); mx_ = MAX3(x0_, x1_, x1_); } \
        float alp_ = 1.0f; const bool resc_ = __any(mx_ > ATT_THR); \
        if (resc_) { const float dl_ = (mx_ > 0.f) ? mx_ : 0.f; alp_ = fast_exp2(-dl_); mref += dl_; lrun *= alp_; \
            _Pragma("unroll") for (int r = 0; r < 16; ++r) { s0[r] -= dl_; s1[r] -= dl_; negm[r] = -mref; } } \
        SB(); \
        LW4(8, gA); o[0] = MF(gA[0], pf[1], o[0]); SB(); EX4(s0, 0); SB(); o[1] = MF(gA[1], pf[1], o[1]); SB(); EX4(s0, 4); SB(); \
        o[2] = MF(gA[2], pf[1], o[2]); SB(); EX4(s0, 8); SB(); o[3] = MF(gA[3], pf[1], o[3]); SB(); EX4(s0, 12); SB(); \
        LW4(4, gB); o[0] = MF(gB[0], pf[2], o[0]); SB(); EX4(s1, 0); SB(); o[1] = MF(gB[1], pf[2], o[1]); SB(); EX4(s1, 4); SB(); \
        o[2] = MF(gB[2], pf[2], o[2]); SB(); EX4(s1, 8); SB(); o[3] = MF(gB[3], pf[2], o[3]); SB(); EX4(s1, 12); SB(); \
        float ls_; \
        LW4(0, gC); o[0] = MF(gC[0], pf[3], o[0]); SB(); \
        ls_ = SUM8(s0, 0); CV8(pf[0], s0, 0); SB(); \
        o[1] = MF(gC[1], pf[3], o[1]); SB(); \
        ls_ = ADDF(ls_, SUM8(s0, 8)); CV8(pf[1], s0, 8); SB(); \
        o[2] = MF(gC[2], pf[3], o[2]); SB(); \
        ls_ = ADDF(ls_, SUM8(s1, 0)); CV8(pf[2], s1, 0); SB(); \
        o[3] = MF(gC[3], pf[3], o[3]); SB(); \
        ls_ = ADDF(ls_, SUM8(s1, 8)); CV8(pf[3], s1, 8); SB(); \
        lrun += ls_; \
        if (resc_) { _Pragma("unroll") for (int eb = 0; eb < 4; ++eb) _Pragma("unroll") for (int r = 0; r < 16; ++r) o[eb][r] *= alp_; } } while (0)
    __builtin_amdgcn_s_waitcnt(0x0F74);
    ATT_BAR();
    if (active) {
        ATT_S0();
#pragma unroll
        for (int r = 0; r < 16; ++r) s0[r] = -INFINITY;
#pragma unroll
        for (int r = 0; r < 8; ++r) s1[r] = -INFINITY;
        DMA_V(1, 1); DMA_K(2, 2); DMA_V(2, 2); if (NT > 3) DMA_K(3, 3);
        ATT_SOFTMAX(true);
    }
    att_wait_vm(6 + (NT > 3 ? 2 : 0));
    int k3 = 0;
#define ATT_HEAD(k) ATT_BAR();                             \
        const int k3p1 = (k3 + 1) & 3; \
        if ((k) + 4 < NT) DMA_K((k) + 4, k3);              \
        if ((k) + 3 < NT) DMA_V((k) + 3, (k3 + 3) & 3);
#define ATT_TAIL(k) att_wait_vm(((k) + 4 < NT ? 2 : 0) + ((k) + 3 < NT ? 4 : 0) + ((k) + 2 < NT ? 2 : 0));     \
        k3 = k3p1;
    for (int k = 0; k < tmax; ++k) {
        ATT_HEAD(k)
        ATT_UNI(k3, k3p1);
        ATT_TAIL(k)
    }
    { ATT_HEAD(tmax)
      ATT_ISSUE(k3);
      ATT_CONSUME(k3, k3p1, false);
      ATT_TAIL(tmax) }
    if (tmax < NT - 1) { ATT_BAR(); att_wait_vm(0); }
#undef ATT_HEAD
#undef ATT_TAIL
#undef DMA16
#undef TILE_ROW0
#undef OFFK
#undef DMA_K
#undef DMA_V
#undef ATT_S0
#undef ATT_ISSUE
#undef ATT_CONSUME
#undef PV4
#undef RDV
#undef RDK
#undef RD128
#undef LW4
#undef SB
#undef MF
#undef ATT_SOFTMAX
#undef MAX3
#undef ATT_UNI
#undef EX4
#undef MFN
#undef ADDF
#undef SUM8
#undef CV8
    { auto rr = __builtin_amdgcn_permlane32_swap(__float_as_uint(lrun), __float_as_uint(lrun), false, false); lrun = __uint_as_float(rr[0]) + __uint_as_float(rr[1]); }
    const float inv = 1.0f / lrun;
    LAS float* ex = (LAS float*)(lds + sub * ATT_XSTRIDE);
    const int e0 = (lane & 15) * 8;
    u32x4 zreg[8]; f32x4 ga, gb;
    if (map == 0) {
        ga = *(const f32x4*)(subg + e0); gb = *(const f32x4*)(subg + e0 + 4);
#pragma unroll
        for (int ps = 0; ps < 8; ++ps) zreg[ps] = __builtin_nontemporal_load((const u32x4*)(Zs + (qbase + 32 * sub + ps * 4 + (lane >> 4)) * DM + h * 128 + e0));
    }
    ATT_BAR();
    if (active && map == 1) {
        const float f = inv * lam;
#pragma unroll
        for (int eb = 0; eb < 4; ++eb)
#pragma unroll
            for (int rq = 0; rq < 4; ++rq) { f32x4 v; v[0] = o[eb][4 * rq] * f; v[1] = o[eb][4 * rq + 1] * f; v[2] = o[eb][4 * rq + 2] * f; v[3] = o[eb][4 * rq + 3] * f;
                *(LAS f32x4*)(ex + r32 * 132 + 32 * eb + 8 * rq + 4 * hi) = v; }
    }
    ATT_BAR();
    if (active && map == 0) {
        float ssq = 0.f;
#pragma unroll
        for (int eb = 0; eb < 4; ++eb)
#pragma unroll
            for (int rq = 0; rq < 4; ++rq) { const f32x4 x = *(const LAS f32x4*)(ex + r32 * 132 + 32 * eb + 8 * rq + 4 * hi);
#pragma unroll
                for (int j = 0; j < 4; ++j) { const float v = o[eb][4 * rq + j] * inv - x[j]; o[eb][4 * rq + j] = v; ssq += v * v; } }
        { auto rr = __builtin_amdgcn_permlane32_swap(__float_as_uint(ssq), __float_as_uint(ssq), false, false); ssq = __uint_as_float(rr[0]) + __uint_as_float(rr[1]); }
        const float rn = rsqrtf(ssq * (1.0f / 128.0f) + EPS) * oml;
#pragma unroll
        for (int eb = 0; eb < 4; ++eb)
#pragma unroll
            for (int rq = 0; rq < 4; ++rq) { f32x4 v; v[0] = o[eb][4 * rq] * rn; v[1] = o[eb][4 * rq + 1] * rn; v[2] = o[eb][4 * rq + 2] * rn; v[3] = o[eb][4 * rq + 3] * rn;
                *(LAS f32x4*)(ex + r32 * 132 + 32 * eb + 8 * rq + 4 * hi) = v; }
        asm volatile("s_waitcnt lgkmcnt(0)" ::: "memory");
#pragma unroll
        for (int ps = 0; ps < 8; ++ps) {
            const int q = ps * 4 + (lane >> 4);
            const size_t row = qbase + 32 * sub + q;
            const f32x4 xa = *(const LAS f32x4*)(ex + q * 132 + e0), xb = *(const LAS f32x4*)(ex + q * 132 + e0 + 4);
            const u32x4 z = zreg[ps];
            u32x4 w;
            w.x = cvt_pk_bf16(xa[0] * ga[0] * bf_lo(z.x), xa[1] * ga[1] * bf_hi(z.x)); w.y = cvt_pk_bf16(xa[2] * ga[2] * bf_lo(z.y), xa[3] * ga[3] * bf_hi(z.y));
            w.z = cvt_pk_bf16(xb[0] * gb[0] * bf_lo(z.z), xb[1] * gb[1] * bf_hi(z.z)); w.w = cvt_pk_bf16(xb[2] * gb[2] * bf_lo(z.w), xb[3] * gb[3] * bf_hi(z.w));
            *(u32x4*)(Ob + row * DM + h * 128 + e0) = w;
        }
    }
    ATT_BAR();
}
__device__ __forceinline__ void attn_phase(LAS unsigned char* lds, const bf16_t* Qb, const bf16_t* Kb, const bf16_t* Vt, const bf16_t* Zs, bf16_t* Ob, const float* subg, float lam, float oml, int vcu, int G) {
    for (int P = vcu; P < 1024; P += G) {
        const int bh = P >> 3, s = P & 7;
        for (int u = 0; u < 2; ++u) attn_unit(lds, Qb, Kb, Vt, Zs, Ob, subg, lam, oml, bh >> 3, bh & 7, u ? 15 - s : s);
    }
}
struct Args {
    const float *x, *meta, *a_norm_g, *a_w_in, *a_conv_w, *a_conv_b, *a_w_out, *kv_norm_g, *w_kv, *b_norm_g, *b_w_in, *lq1, *lk1, *lq2, *lk2, *subln_g, *b_w_out, *final_g;
    float* out; unsigned char* ws;
};
struct TrItem { const float* src; const float* g; bf16_t* dst; int N; };
__device__ __forceinline__ TrItem tr_decode(const Args& a, int it, int lane) {
    unsigned char* ws = a.ws;
    constexpr int I_AIN = 16 * 64, I_SQ = 16 * 16, I_BIN = 16 * 32;
    const float* W; const float* g; bf16_t* WT; int N, col_off = 0, row_off = 0, nblk; bool perma = false;
    int r = it;
    if (r < 2 * I_AIN) { const int l = r / I_AIN; r -= l * I_AIN; W = a.a_w_in + (size_t)l * DM * 4096; N = 4096; g = a.a_norm_g + l * DM; WT = (bf16_t*)(ws + WS_WAIN) + (size_t)l * 4096 * DM; nblk = 64; perma = true; }
    else { r -= 2 * I_AIN;
    if (r < 2 * I_SQ) { const int l = r / I_SQ; r -= l * I_SQ; W = a.a_w_out + (size_t)l * DM * DM; N = DM; g = nullptr; WT = (bf16_t*)(ws + WS_WAOUT) + (size_t)l * DM * DM; nblk = 16; }
    else { r -= 2 * I_SQ;
    if (r < I_SQ) { W = a.w_kv; N = 2048; g = a.kv_norm_g; WT = (bf16_t*)(ws + WS_WKQZ); nblk = 16; }
    else { r -= I_SQ;
    if (r < I_SQ) { W = a.w_kv; N = 2048; col_off = 1024; g = a.kv_norm_g; WT = (bf16_t*)(ws + WS_WVT); nblk = 16; }
    else { r -= I_SQ;
    if (r < I_BIN) { W = a.b_w_in; N = 2048; g = a.b_norm_g; WT = (bf16_t*)(ws + WS_WKQZ); row_off = 1024; nblk = 32; }
    else { r -= I_BIN;
    if (r < I_BIN) { W = a.b_w_in + (size_t)DM * 2048; N = 2048; g = a.b_norm_g + DM; WT = (bf16_t*)(ws + WS_WQZ1); nblk = 32; }
    else { r -= I_BIN; const int l = r / I_SQ; r -= l * I_SQ; W = a.b_w_out + (size_t)l * DM * DM; N = DM; g = nullptr; WT = (bf16_t*)(ws + WS_WBOUT) + (size_t)l * DM * DM; nblk = 16; } } } } } }
    const int kb = r / nblk, nb = r - kb * nblk, k0 = 64 * kb, n0 = 64 * nb, nq = lane & 15, kr = lane >> 4;
    const int np = n0 + 4 * nq; int src;
    if (perma) { const int pn = np >> 8, bj = (np >> 7) & 1, wc = (np >> 5) & 3, nn = (np >> 4) & 1, low = np & 15; src = (2 * bj + nn) * 1024 + 64 * pn + 16 * wc + low; }
    else src = col_off + np;
    TrItem t; t.src = W + (size_t)(k0 + kr) * N + src; t.g = g ? g + k0 : nullptr; t.dst = WT + (size_t)(row_off + n0) * DM + k0; t.N = N;
    return t;
}
__device__ __forceinline__ void tr_load(const TrItem& t, f32x4 (&v)[16]) {
#pragma unroll
    for (int i = 0; i < 16; ++i) v[i] = __builtin_nontemporal_load((const f32x4*)(t.src + (size_t)(4 * i) * t.N));
}
__device__ __forceinline__ void tr_store(const TrItem& t, const f32x4 (&v)[16], LAS float* scr, int lane) {
    const int nq = lane & 15, kr = lane >> 4;
#pragma unroll
    for (int i = 0; i < 16; ++i) { const int kk = 4 * i + kr; const float gg = t.g ? t.g[kk] : 1.0f;
        scr[kk * 65 + 4 * nq + 0] = v[i][0] * gg; scr[kk * 65 + 4 * nq + 1] = v[i][1] * gg; scr[kk * 65 + 4 * nq + 2] = v[i][2] * gg; scr[kk * 65 + 4 * nq + 3] = v[i][3] * gg; }
    asm volatile("s_waitcnt lgkmcnt(0)" ::: "memory");
    const int c = lane & 7;
#pragma unroll
    for (int j = 0; j < 8; ++j) { const int n = (lane >> 3) + 8 * j; const LAS float* s = scr + (8 * c) * 65 + n;
        u32x4 o; o.x = cvt_pk_bf16(s[0 * 65], s[1 * 65]); o.y = cvt_pk_bf16(s[2 * 65], s[3 * 65]); o.z = cvt_pk_bf16(s[4 * 65], s[5 * 65]); o.w = cvt_pk_bf16(s[6 * 65], s[7 * 65]);
        *(u32x4*)(t.dst + (size_t)n * DM + 8 * c) = o; }
    asm volatile("s_waitcnt lgkmcnt(0)" ::: "memory");
}
__device__ __forceinline__ void prologue(const Args& a, LAS unsigned char* lds, int gw, int NGW, int wave, int lane) {
    LAS float* scr = (LAS float*)(lds + wave * 16640);
    unsigned char* ws = a.ws;
    constexpr int NITEMS = 2 * (16 * 64) + 2 * 256 + 2 * 256 + 2 * (16 * 32) + 2 * 256;
    if (gw < NITEMS) {
        TrItem cur = tr_decode(a, gw, lane); f32x4 v[16]; tr_load(cur, v);
        for (int it = gw; it < NITEMS; it += NGW) {
            const bool more = it + NGW < NITEMS;
            TrItem nxt = cur; f32x4 vn[16];
            if (more) { nxt = tr_decode(a, it + NGW, lane); tr_load(nxt, vn); }
            tr_store(cur, v, scr, lane);
            if (more) { cur = nxt;
#pragma unroll
                for (int i = 0; i < 16; ++i) v[i] = vn[i]; }
        }
    }
    bf16_t* hb = (bf16_t*)(ws + WS_HB); float* part = (float*)(ws + WS_SS);
#define H0_LOAD(dst, r0) do { _Pragma("unroll") for (int q = 0; q < 4; ++q) { const int row_ = (r0) + q; const float* src_ = (row_ < MF) ? a.x + (size_t)row_ * DM : a.meta + (size_t)(row_ - MF) * DM; \
        _Pragma("unroll") for (int j = 0; j < 4; ++j) dst[q][j] = __builtin_nontemporal_load((const f32x4*)(src_ + 4 * lane + 256 * j)); } } while (0)
    if (gw * 4 < MF + NMETA) {
        f32x4 v[4][4]; H0_LOAD(v, gw * 4);
        for (int row0 = gw * 4; row0 < MF + NMETA; row0 += NGW * 4) {
            const bool more = row0 + NGW * 4 < MF + NMETA;
            f32x4 vn[4][4];
            if (more) H0_LOAD(vn, row0 + NGW * 4);
#pragma unroll
            for (int q = 0; q < 4; ++q) { const int row = row0 + q; float ss = 0.f;
#pragma unroll
                for (int j = 0; j < 4; ++j) { const f32x4 x = v[q][j];
                    ss += (x[0] * x[0] + x[1] * x[1]) + (x[2] * x[2] + x[3] * x[3]);
                    u32x2 w; w.x = cvt_pk_bf16(x[0], x[1]); w.y = cvt_pk_bf16(x[2], x[3]);
                    *(u32x2*)(hb + (size_t)row * DM + 4 * lane + 256 * j) = w; }
                ss = wave_sum(ss);
                if (lane < 16) part[(size_t)row * 16 + lane] = (lane == 0) ? ss : 0.f; }
            if (more) {
#pragma unroll
                for (int q = 0; q < 4; ++q)
#pragma unroll
                    for (int j = 0; j < 4; ++j) v[q][j] = vn[q][j]; }
        }
    }
#undef H0_LOAD
}
__device__ __forceinline__ void conv_phase(const bf16_t* __restrict__ v, const bf16_t* __restrict__ gz, bf16_t* __restrict__ y, const float* __restrict__ cw, const float* __restrict__ cb, int bid, int G, int tid) {
    const int cg8 = (tid & 127) * 8, rsub = tid >> 7;
    float w0[8], w1[8], w2[8], bb[8];
#pragma unroll
    for (int i = 0; i < 8; ++i) { w0[i] = cw[cg8 + i]; w1[i] = cw[DM + cg8 + i]; w2[i] = cw[2 * DM + cg8 + i]; bb[i] = cb[cg8 + i]; }
    for (int i = bid * 4 + rsub; i < MF / 32 + NMETA; i += G * 4) {
        const int r = (i < MF / 32) ? (i >> 1) * 64 + (i & 1) : MF + (i - MF / 32);
        int r1, r2;
        if (r < MF) { const int t = r & (SEQ - 1); r1 = (t >= 1) ? r - 1 : HM + 15; r2 = (t >= 2) ? r - 2 : HM + 14 + t; }
        else { const int mm = r - MF; r1 = (mm >= 1) ? r - 1 : -1; r2 = (mm >= 2) ? r - 2 : -1; }
        const u32x4 zero = (u32x4){0u, 0u, 0u, 0u};
        const u32x4 a0 = *(const u32x4*)(v + (size_t)r * DM + cg8);
        const u32x4 a1 = (r1 >= 0) ? *(const u32x4*)(v + (size_t)r1 * DM + cg8) : zero;
        const u32x4 a2 = (r2 >= 0) ? *(const u32x4*)(v + (size_t)r2 * DM + cg8) : zero;
        const u32x4 gg = *(const u32x4*)(gz + (size_t)r * DM + cg8);
        float o[8];
#pragma unroll
        for (int i = 0; i < 4; ++i) {
            const unsigned x0 = a0[i], x1 = a1[i], x2 = a2[i], gx = gg[i];
            o[2 * i] = bf_lo(gx) * (w0[2 * i] * bf_lo(x2) + w1[2 * i] * bf_lo(x1) + w2[2 * i] * bf_lo(x0) + bb[2 * i]);
            o[2 * i + 1] = bf_hi(gx) * (w0[2 * i + 1] * bf_hi(x2) + w1[2 * i + 1] * bf_hi(x1) + w2[2 * i + 1] * bf_hi(x0) + bb[2 * i + 1]);
        }
        u32x4 w; w.x = cvt_pk_bf16(o[0], o[1]); w.y = cvt_pk_bf16(o[2], o[3]); w.z = cvt_pk_bf16(o[4], o[5]); w.w = cvt_pk_bf16(o[6], o[7]);
        *(u32x4*)(y + (size_t)r * DM + cg8) = w;
    }
}
__device__ __forceinline__ void final_phase(const bf16_t* __restrict__ hb, const float* __restrict__ part, const float* __restrict__ fg, float* __restrict__ out, int gw, int NGW, int lane) {
    f32x4 g[4];
#pragma unroll
    for (int j = 0; j < 2; ++j) { g[2 * j] = *(const f32x4*)(fg + 8 * lane + 512 * j); g[2 * j + 1] = *(const f32x4*)(fg + 8 * lane + 512 * j + 4); }
    for (int orow = gw; orow < MF; orow += NGW) {
        const size_t row = (size_t)orow;
        float s = part[row * 16 + (lane & 15)];
        s += __shfl_xor(s, 1); s += __shfl_xor(s, 2); s += __shfl_xor(s, 4); s += __shfl_xor(s, 8);
        const float rs = rsqrtf(s * (1.0f / DM) + EPS);
#pragma unroll
        for (int j = 0; j < 2; ++j) {
            const u32x4 hv = __builtin_nontemporal_load((const u32x4*)(hb + row * DM + 8 * lane + 512 * j));
            f32x4 o0, o1;
            o0[0] = bf_lo(hv.x) * rs * g[2 * j][0]; o0[1] = bf_hi(hv.x) * rs * g[2 * j][1]; o0[2] = bf_lo(hv.y) * rs * g[2 * j][2]; o0[3] = bf_hi(hv.y) * rs * g[2 * j][3];
            o1[0] = bf_lo(hv.z) * rs * g[2 * j + 1][0]; o1[1] = bf_hi(hv.z) * rs * g[2 * j + 1][1]; o1[2] = bf_lo(hv.w) * rs * g[2 * j + 1][2]; o1[3] = bf_hi(hv.w) * rs * g[2 * j + 1][3];
            __builtin_nontemporal_store(o0, (f32x4*)(out + (size_t)orow * DM + 8 * lane + 512 * j)); __builtin_nontemporal_store(o1, (f32x4*)(out + (size_t)orow * DM + 8 * lane + 512 * j + 4));
        }
    }
}
typedef const __attribute__((address_space(4))) Args* CArgsP;
#define AP() ({ CArgsP p_ = (CArgsP)__builtin_amdgcn_kernarg_segment_ptr(); asm volatile("" : "+s"(p_)); p_; })
#define WSB(off) ((bf16_t*)(ws + (off)))
#define GRID_BAR() do { XcdBarrier bb_; bb_.bar = (unsigned*)(AP()->ws + WS_CTL); bb_.x = xb_xcc_id(); bb_.st = (volatile LAS unsigned*)(lds + 131072 + 128); xcd_barrier(bb_); } while (0)
__global__ void __launch_bounds__(512, 2) yoco_fwd(Args a_unused) {
    extern __shared__ __attribute__((aligned(16))) unsigned char lds_raw[];
    LAS unsigned char* lds = (LAS unsigned char*)lds_raw;
    cg::grid_group grid = cg::this_grid();
    const int G = gridDim.x, bx = blockIdx.x;
    const int vcu = (G % 8 == 0) ? (bx % 8) * (G / 8) + bx / 8 : bx;
    {
        CArgsP ap = AP(); unsigned char* ws = ap->ws;
        int tid = threadIdx.x; asm volatile("" : "+v"(tid));
        const int lane = tid & 63, wave = __builtin_amdgcn_readfirstlane(tid >> 6);
        if (bx == 0) { for (int i = tid; i < 4096; i += 512) ((unsigned*)(ws + WS_CTL))[i] = 0u; }
        Args acopy; { const __attribute__((address_space(4))) unsigned long long* s_ = (const __attribute__((address_space(4))) unsigned long long*)ap; unsigned long long* d_ = (unsigned long long*)&acopy;
#pragma unroll
          for (int i = 0; i < (int)(sizeof(Args) / 8); ++i) d_[i] = s_[i]; }
        prologue(acopy, lds, vcu * 8 + wave, G * 8, wave, lane);
        __syncthreads();
        if (tid < 2) ((volatile LAS unsigned*)(lds + 131072 + 128))[tid] = 0u;
    }
    grid.sync();
    if (threadIdx.x == 0) { const unsigned r_ = xb_add((unsigned*)(AP()->ws + WS_CTL) + XB_XCNT(xb_xcc_id()), 1u); ((volatile LAS unsigned*)(lds + 131072 + 128))[2] = r_; }
    __syncthreads();
#define REAL_CU(out_c, out_v) do { unsigned* bar_ = (unsigned*)(AP()->ws + WS_CTL); bool ok_ = (G % 8 == 0); \
        for (int j_ = 0; j_ < 8; ++j_) ok_ = ok_ && (xb_ld(&bar_[XB_XCNT(j_)]) == (unsigned)(G / 8)); \
        const int x_ = (int)xb_xcc_id(), r_ = (int)((volatile LAS unsigned*)(lds + 131072 + 128))[2]; \
        ok_ = ok_ && x_ < 8 && r_ < G / 8; \
        out_c = ok_ ? r_ * 8 + x_ : bx;                   \
        out_v = ok_ ? x_ * (G / 8) + r_ : vcu;            \
        out_c = __builtin_amdgcn_readfirstlane(out_c); out_v = __builtin_amdgcn_readfirstlane(out_v); } while (0)
#pragma unroll 1
    for (int layer = 0; layer < 4; ++layer) {
        if (layer < 2) {
            { CArgsP ap = AP(); unsigned char* ws = ap->ws; bf16_t* hb = WSB(WS_HB); float* part = (float*)(ws + WS_SS);
              const bf16_t* Wl = WSB(WS_WAIN) + (size_t)layer * 4096 * DM;
              int t2 = threadIdx.x; asm volatile("" : "+v"(t2));
              if (vcu < 64) meta_ain_job(vcu, hb, Wl, part, WSB(WS_BUF0), WSB(WS_BUF1), __builtin_amdgcn_readfirstlane(t2 >> 6), t2 & 63, lds);
              pg8::Gemm g{hb, Wl, MF, 4096, DM}; pg8::StaticOrder S; S.init(MF, 4096, G, bx);
              EpiAIn E{part, WSB(WS_BUF0), WSB(WS_BUF1), WSB(WS_BUF2), ap->a_conv_w + (size_t)layer * 3 * DM, ap->a_conv_b + (size_t)layer * DM};
              pg8::gemm_phase<EpiAIn, pg8::StaticOrder, true, true>(lds, g, S, E); }
            GRID_BAR();
            { CArgsP ap = AP(); unsigned char* ws = ap->ws; int t2 = threadIdx.x; asm volatile("" : "+v"(t2));
              conv_phase(WSB(WS_BUF0), WSB(WS_BUF1), WSB(WS_BUF2), ap->a_conv_w + (size_t)layer * 3 * DM, ap->a_conv_b + (size_t)layer * DM, bx, G, t2); }
            GRID_BAR();
        } else {
            const int lb = layer - 2;
            if (lb == 0) {
              CArgsP ap = AP(); unsigned char* ws = ap->ws; bf16_t* hb = WSB(WS_HB); float* part = (float*)(ws + WS_SS);
              int t2 = threadIdx.x; asm volatile("" : "+v"(t2)); const int wv = __builtin_amdgcn_readfirstlane(t2 >> 6);
              if (bx == G - 1) { for (int i = t2; i < PADR * DM / 8; i += 512) *(u32x4*)(WSB(WS_BUF0) + (size_t)KM * DM + (size_t)i * 8) = (u32x4){0u, 0u, 0u, 0u}; }
              if (bx == G - 2) { for (int i = t2; i < 1024 * 6; i += 512) *(u32x4*)(WSB(WS_BUF3) + (size_t)(i / 6) * VP + MF + (i % 6) * 8) = (u32x4){0u, 0u, 0u, 0u}; }
              if (vcu < 16) meta_k_job(vcu, hb, WSB(WS_WKQZ), part, WSB(WS_BUF0), wv, t2 & 63, lds);
              else if (vcu < 32) meta_v_job(vcu - 16, hb, WSB(WS_WVT), part, WSB(WS_BUF3), wv, t2 & 63, lds); }
            { CArgsP ap = AP(); unsigned char* ws = ap->ws;
              pg8::Gemm g{WSB(WS_HB), lb ? WSB(WS_WQZ1) : WSB(WS_WKQZ), MF, lb ? 2048 : 3072, DM}; pg8::StaticOrder S; S.init(MF, lb ? 2048 : 3072, G, bx);
              EpiKQZ E{(const float*)(ws + WS_SS), WSB(WS_BUF0), lb ? 1 : 0};
              pg8::gemm_phase<EpiKQZ, pg8::StaticOrder, true, true>(lds, g, S, E); }
            if (lb == 0) {
              CArgsP ap = AP(); unsigned char* ws = ap->ws;
              pg8::Gemm g{WSB(WS_WVT), WSB(WS_HB), DM, MF, DM}; pg8::StaticOrder S; S.init(DM, MF, G, bx);
              EpiVt E{(const float*)(ws + WS_SS), WSB(WS_BUF3)};
              pg8::gemm_phase<EpiVt, pg8::StaticOrder, true, true>(lds, g, S, E); }
            GRID_BAR();
            { CArgsP ap = AP(); unsigned char* ws = ap->ws;
              float lam, oml;
              { int l2 = threadIdx.x; asm volatile("" : "+v"(l2)); l2 &= 63; const float p1 = ap->lq1[lb * 64 + l2] * ap->lk1[lb * 64 + l2], p2 = ap->lq2[lb * 64 + l2] * ap->lk2[lb * 64 + l2];
                const float li = 0.8f - 0.6f * expf(-0.3f * (float)layer);
                lam = expf(wave_sum(p1)) - expf(wave_sum(p2)) + li; oml = 1.0f - li;
                lam = __uint_as_float(__builtin_amdgcn_readfirstlane(__float_as_uint(lam))); oml = __uint_as_float(__builtin_amdgcn_readfirstlane(__float_as_uint(oml))); }
              int rc_, rv_; REAL_CU(rc_, rv_);
              attn_phase(lds, WSB(WS_BUF1), WSB(WS_BUF0), WSB(WS_BUF3), WSB(WS_BUF2), WSB(WS_BUF1), ap->subln_g + lb * 128, lam, oml, rv_, G); }
            GRID_BAR();
        }
        { CArgsP ap = AP(); unsigned char* ws = ap->ws; bf16_t* hb = WSB(WS_HB); float* part = (float*)(ws + WS_SS);
          const bf16_t* Aout = (layer < 2) ? WSB(WS_BUF2) : WSB(WS_BUF1);
          const bf16_t* Wout = (layer < 2) ? WSB(WS_WAOUT) + (size_t)layer * DM * DM : WSB(WS_WBOUT) + (size_t)(layer - 2) * DM * DM;
          int t2 = threadIdx.x; asm volatile("" : "+v"(t2));
          if (layer < 2 && vcu < 16) meta_res_job(vcu, Aout, Wout, hb, part, __builtin_amdgcn_readfirstlane(t2 >> 6), t2 & 63, lds);
          pg8::Gemm g{Aout, Wout, MF, DM, DM}; pg8::StaticOrder S; S.init(MF, DM, G, bx);
          EpiRes E{hb, part};
          pg8::gemm_phase<EpiRes, pg8::StaticOrder, true, true>(lds, g, S, E); }
        GRID_BAR();
    }
    { CArgsP ap = AP(); unsigned char* ws = ap->ws; int t2 = threadIdx.x; asm volatile("" : "+v"(t2));
      final_phase(WSB(WS_HB), (const float*)(ws + WS_SS), ap->final_g, ap->out, vcu * 8 + __builtin_amdgcn_readfirstlane(t2 >> 6), G * 8, t2 & 63); }
}

extern "C" void kernel_launch(void* const* d_in, const int* in_sizes, int n_in, void* d_out, int out_size, void* d_ws, size_t ws_size, hipStream_t stream) {
    static int grid = 0;
    if (grid == 0) {
        int dev = 0, cus = 0, per = 0;
        if (n_in != 18 || out_size != MF * DM || ws_size < WS_END) { fprintf(stderr, "kernel_launch: unexpected shapes (n_in %d out %d ws %zu)\n", n_in, out_size, ws_size); grid = -1; return; }
        (void)hipGetDevice(&dev); (void)hipDeviceGetAttribute(&cus, hipDeviceAttributeMultiprocessorCount, dev);
        (void)hipFuncSetAttribute((const void*)yoco_fwd, hipFuncAttributeMaxDynamicSharedMemorySize, LDS_BYTES);
        (void)hipOccupancyMaxActiveBlocksPerMultiprocessor(&per, (const void*)yoco_fwd, 512, LDS_BYTES);
        if (per < 1) per = 1;
        grid = cus * per;
        fprintf(stderr, "kernel_launch: grid %d (cus %d x %d)\n", grid, cus, per);
    }
    if (grid < 0) return;
    Args a{};
    const float** ap = (const float**)&a;
    for (int i = 0; i < 18; ++i) ap[i] = (const float*)d_in[i];
    a.out = (float*)d_out; a.ws = (unsigned char*)d_ws;
    void* args[] = {&a};
    hipError_t e = hipLaunchCooperativeKernel((const void*)yoco_fwd, dim3(grid), dim3(512), args, LDS_BYTES, stream);
    if (e != hipSuccess) fprintf(stderr, "cooperative launch failed: %s (grid %d)\n", hipGetErrorString(e), grid);
}
```
